# Optimizing an MI355X kernel written in HIP

```python
import jax, jax.numpy as jnp
from jax import lax
import numpy as np

D_MODEL = 1024
BATCH = 4
SEQ = 4096
DEPTH = 4

GRID_W = 64
CTX_LEN = 256
N_MIXERS = 2
N_A = (DEPTH + 1) // 2
N_B = DEPTH // 2
MLA_HEADS = 8
QK_NOPE = 128
QK_ROPE = 64
V_DIM = 128
QK_DIM = QK_NOPE + QK_ROPE
Q_LORA = 384
KV_LORA = 256
ROPE_THETA = 10000.0
Q_BLOCK = 128
GM_CHUNK = 128
GM_GROUPS = 8
GM_HALF = 2 * D_MODEL
GM_GROUP_DIM = GM_HALF // GM_GROUPS
FFN_HIDDEN = 4 * D_MODEL
N_MOD = 6
EPS = 1e-6

kernel_name = "hybrid_mla_gmlp_prefix_dit"


def rmsnorm(x, g):
    xf = x.astype(jnp.float32)
    y = xf * lax.rsqrt(jnp.mean(xf * xf, axis=-1, keepdims=True) + EPS)
    return (y * g.astype(jnp.float32)).astype(x.dtype)


def layernorm(x, g, b):
    xf = x.astype(jnp.float32)
    mu = jnp.mean(xf, axis=-1, keepdims=True)
    var = jnp.mean(jnp.square(xf - mu), axis=-1, keepdims=True)
    y = (xf - mu) * lax.rsqrt(var + EPS)
    return (y * g.astype(jnp.float32) + b.astype(jnp.float32)).astype(x.dtype)


def modulate(x, g, shift, scale):
    return rmsnorm(x, g) * (1.0 + scale) + shift


def axial_rope_tables(n_tokens, dtype):
    rows = n_tokens // GRID_W
    row = jnp.repeat(jnp.arange(rows, dtype=jnp.float32), GRID_W)
    col = jnp.tile(jnp.arange(GRID_W, dtype=jnp.float32), rows)
    half = QK_ROPE // 2
    inv = ROPE_THETA ** (-jnp.arange(0, half, 2, dtype=jnp.float32) / half)
    ang_r = row[:, None] * inv[None, :]
    ang_c = col[:, None] * inv[None, :]
    ang = jnp.concatenate([ang_r, ang_r, ang_c, ang_c], axis=-1)
    return jnp.cos(ang).astype(dtype), jnp.sin(ang).astype(dtype)


def rotate_axial(x):
    a1, a2, b1, b2 = jnp.split(x, 4, axis=-1)
    return jnp.concatenate([-a2, a1, -b2, b1], axis=-1)


def rope_part(t, cos, sin):
    nope, pe = t[..., :QK_NOPE], t[..., QK_NOPE:]
    c = cos[None, :, None, :]
    s = sin[None, :, None, :]
    return jnp.concatenate([nope, pe * c + rotate_axial(pe) * s], axis=-1)


def block_attention(q, k, v, scale):
    B, Sq, H, Dk = q.shape
    nb = Sq // Q_BLOCK
    qb = q.reshape(B, nb, Q_BLOCK, H, Dk).transpose(1, 0, 2, 3, 4)

    def one(qi):
        s = jnp.einsum('bqhd,bkhd->bhqk', qi, k, preferred_element_type=jnp.float32) * scale
        p = jax.nn.softmax(s, axis=-1)
        return jnp.einsum('bhqk,bkhd->bqhd', p.astype(v.dtype), v)

    o = lax.map(one, qb)
    return o.transpose(1, 0, 2, 3, 4).reshape(B, Sq, H, v.shape[-1])


def mla_queries(h, wq_a, q_a_norm, wq_b, q_norm):
    B, S, _ = h.shape
    cq = rmsnorm(h @ wq_a, q_a_norm)
    q = (cq @ wq_b).reshape(B, S, MLA_HEADS, QK_DIM)
    return rmsnorm(q, q_norm)


def mla_keys_values(h, wkv_a, kv_a_norm, wkv_b, k_norm):
    B, S, _ = h.shape
    kv_a = h @ wkv_a
    ckv, k_pe = kv_a[..., :KV_LORA], kv_a[..., KV_LORA:]
    kv = (rmsnorm(ckv, kv_a_norm) @ wkv_b).reshape(B, S, MLA_HEADS, QK_NOPE + V_DIM)
    k_nope, v = kv[..., :QK_NOPE], kv[..., QK_NOPE:]
    k_pe = jnp.broadcast_to(k_pe[:, :, None, :], (B, S, MLA_HEADS, QK_ROPE))
    k = rmsnorm(jnp.concatenate([k_nope, k_pe], axis=-1), k_norm)
    return k, v


def mla_mixer(h_lat, h_ctx, cos, sin, wq_a, q_a_norm, wq_b, wkv_a, kv_a_norm, wkv_b,
              q_norm, k_norm, wo, with_ctx):
    B, S, _ = h_lat.shape
    scale = QK_DIM ** -0.5
    k_lat, v_lat = mla_keys_values(h_lat, wkv_a, kv_a_norm, wkv_b, k_norm)
    k_ctx, v_ctx = mla_keys_values(h_ctx, wkv_a, kv_a_norm, wkv_b, k_norm)
    k_lat = rope_part(k_lat, cos, sin)
    q_lat = rope_part(mla_queries(h_lat, wq_a, q_a_norm, wq_b, q_norm), cos, sin)
    k_all = jnp.concatenate([k_ctx, k_lat], axis=1)
    v_all = jnp.concatenate([v_ctx, v_lat], axis=1)
    o_lat = block_attention(q_lat, k_all, v_all, scale).reshape(B, S, MLA_HEADS * V_DIM) @ wo
    o_ctx = None
    if with_ctx:
        q_ctx = mla_queries(h_ctx, wq_a, q_a_norm, wq_b, q_norm)
        o_ctx = block_attention(q_ctx, k_ctx, v_ctx, scale).reshape(
            B, h_ctx.shape[1], MLA_HEADS * V_DIM) @ wo
    return o_lat, o_ctx


def gmlp_mixer(h, w_in, ln_g, ln_b, ws, bs, w_out):
    B, S, _ = h.shape
    z = jax.nn.gelu(h @ w_in, approximate=False)
    u, v = z[..., :GM_HALF], z[..., GM_HALF:]
    v = layernorm(v, ln_g, ln_b)
    vc = v.reshape(B, S // GM_CHUNK, GM_CHUNK, GM_GROUPS, GM_GROUP_DIM)
    mixed = jnp.einsum('gpq,bnqgc->bnpgc', ws, vc) + bs.T[None, None, :, :, None]
    return (u * mixed.reshape(B, S, GM_HALF)) @ w_out


def squared_relu_mlp(h, w1, w2):
    return jnp.square(jax.nn.relu(h @ w1)) @ w2


def setup_inputs(seed: int = 0) -> dict:
    key = jax.random.key(seed)
    ks = jax.random.split(key, 32)
    D = D_MODEL

    def nrm(k, shape, scale):
        return jax.random.normal(k, shape, jnp.float32) * scale

    def gain(k, shape):
        return 1.0 + 0.05 * jax.random.normal(k, shape, jnp.float32)

    return {
        "x": nrm(ks[0], (BATCH, SEQ, D), 1.0),
        "c": nrm(ks[1], (BATCH, D), 1.0),
        "ctx": nrm(ks[2], (BATCH, CTX_LEN, D), 1.0),
        "c_ctx": nrm(ks[3], (D,), 1.0),
        "ada_w": nrm(ks[4], (DEPTH, D, N_MOD * D), 0.5 * D ** -0.5),
        "ada_b": nrm(ks[5], (DEPTH, N_MOD * D), 0.01),
        "norm_mix_g": gain(ks[6], (DEPTH, D)),
        "norm_ffn_g": gain(ks[7], (DEPTH, D)),
        "mla_wq_a": nrm(ks[8], (N_A, D, Q_LORA), D ** -0.5),
        "mla_q_a_norm": gain(ks[9], (N_A, Q_LORA)),
        "mla_wq_b": nrm(ks[10], (N_A, Q_LORA, MLA_HEADS * QK_DIM), Q_LORA ** -0.5),
        "mla_wkv_a": nrm(ks[11], (N_A, D, KV_LORA + QK_ROPE), D ** -0.5),
        "mla_kv_a_norm": gain(ks[12], (N_A, KV_LORA)),
        "mla_wkv_b": nrm(ks[13], (N_A, KV_LORA, MLA_HEADS * (QK_NOPE + V_DIM)), KV_LORA ** -0.5),
        "mla_q_norm": gain(ks[14], (N_A, QK_DIM)),
        "mla_k_norm": gain(ks[15], (N_A, QK_DIM)),
        "mla_wo": nrm(ks[16], (N_A, MLA_HEADS * V_DIM, D), (MLA_HEADS * V_DIM) ** -0.5),
        "gm_w_in": nrm(ks[17], (N_B, D, 2 * GM_HALF), D ** -0.5),
        "gm_ln_g": gain(ks[18], (N_B, GM_HALF)),
        "gm_ln_b": nrm(ks[19], (N_B, GM_HALF), 0.02),
        "gm_ws": nrm(ks[20], (N_B, GM_GROUPS, GM_CHUNK, GM_CHUNK), GM_CHUNK ** -0.5),
        "gm_bs": gain(ks[21], (N_B, GM_GROUPS, GM_CHUNK)),
        "gm_w_out": nrm(ks[22], (N_B, GM_HALF, D), GM_HALF ** -0.5),
        "ffn_w1": nrm(ks[23], (DEPTH, D, FFN_HIDDEN), D ** -0.5),
        "ffn_w2": nrm(ks[24], (DEPTH, FFN_HIDDEN, D), FFN_HIDDEN ** -0.5),
    }


def reference(x, c, ctx, c_ctx, ada_w, ada_b, norm_mix_g, norm_ffn_g,
              mla_wq_a, mla_q_a_norm, mla_wq_b, mla_wkv_a, mla_kv_a_norm, mla_wkv_b,
              mla_q_norm, mla_k_norm, mla_wo,
              gm_w_in, gm_ln_g, gm_ln_b, gm_ws, gm_bs, gm_w_out,
              ffn_w1, ffn_w2):
    S = x.shape[1]
    cos, sin = axial_rope_tables(S, x.dtype)
    silu_c = jax.nn.silu(c)
    silu_cc = jax.nn.silu(c_ctx)
    y = ctx
    for i in range(DEPTH):
        with_ctx = i < DEPTH - 1
        use_mla = (i % N_MIXERS) == 0
        j = i // N_MIXERS
        m_lat = (silu_c @ ada_w[i] + ada_b[i])[:, None, :]
        m_ctx = silu_cc @ ada_w[i] + ada_b[i]
        sh_m, sc_m, g_m, sh_f, sc_f, g_f = jnp.split(m_lat, N_MOD, axis=-1)
        csh_m, csc_m, cg_m, csh_f, csc_f, cg_f = jnp.split(m_ctx, N_MOD, axis=-1)

        h_lat = modulate(x, norm_mix_g[i], sh_m, sc_m)
        if use_mla:
            h_ctx = modulate(y, norm_mix_g[i], csh_m, csc_m)
            o_lat, o_ctx = mla_mixer(h_lat, h_ctx, cos, sin, mla_wq_a[j], mla_q_a_norm[j],
                                     mla_wq_b[j], mla_wkv_a[j], mla_kv_a_norm[j], mla_wkv_b[j],
                                     mla_q_norm[j], mla_k_norm[j], mla_wo[j], with_ctx)
        else:
            o_lat = gmlp_mixer(h_lat, gm_w_in[j], gm_ln_g[j], gm_ln_b[j], gm_ws[j], gm_bs[j],
                               gm_w_out[j])
            o_ctx = None
            if with_ctx:
                h_ctx = modulate(y, norm_mix_g[i], csh_m, csc_m)
                o_ctx = gmlp_mixer(h_ctx, gm_w_in[j], gm_ln_g[j], gm_ln_b[j], gm_ws[j], gm_bs[j],
                                   gm_w_out[j])
        x = x + g_m * o_lat
        x = x + g_f * squared_relu_mlp(modulate(x, norm_ffn_g[i], sh_f, sc_f), ffn_w1[i], ffn_w2[i])
        if with_ctx:
            y = y + cg_m * o_ctx
            y = y + cg_f * squared_relu_mlp(modulate(y, norm_ffn_g[i], csh_f, csc_f),
                                            ffn_w1[i], ffn_w2[i])
    return x
```

```cpp
#include <hip/hip_runtime.h>
#include <hip/hip_cooperative_groups.h>
#include <hip/hip_bf16.h>
#include <cstdio>
#include <cstdint>
namespace cg = cooperative_groups;

#ifndef ONE_LAUNCH
#define ONE_LAUNCH 0
#endif

constexpr int DM = 1024, NB = 4, SEQ = 4096, CTX = 256, DEPTH = 4;
constexpr int MLAT = NB * SEQ, MCTX = NB * CTX, MALL = MLAT + MCTX;
constexpr int NH = 8, QKN = 128, QKR = 64, VD = 128, QKD = 192, QLORA = 384, KVLORA = 256;
constexpr int NQKVA = 768;
constexpr int GMH = 2048, FFH = 4096, NMOD = 6 * DM;
constexpr float EPS = 1e-6f;

#define LAS __attribute__((address_space(3)))
typedef unsigned short bf16_t;
typedef short bf16x8 __attribute__((ext_vector_type(8)));
typedef float f32x4 __attribute__((ext_vector_type(4)));
typedef float f32x2 __attribute__((ext_vector_type(2)));
typedef unsigned u32x4 __attribute__((ext_vector_type(4)));
typedef unsigned u32x2 __attribute__((ext_vector_type(2)));

__device__ __forceinline__ unsigned cvt_pk_bf16(float lo, float hi) { unsigned r; asm volatile("v_cvt_pk_bf16_f32 %0, %1, %2" : "=v"(r) : "v"(lo), "v"(hi)); return r; }
__device__ __forceinline__ float bf_lo(unsigned w) { return __uint_as_float(w << 16); }
__device__ __forceinline__ float bf_hi(unsigned w) { return __uint_as_float(w & 0xffff0000u); }
__device__ __forceinline__ float wave_sum(float v) {
#pragma unroll
    for (int o = 1; o < 64; o <<= 1) v += __shfl_xor(v, o);
    return v;
}

namespace pg8 {
#define PG8_LAS __attribute__((address_space(3)))
constexpr int BM = 256, BK = 64, HALF = 128, HTB = HALF * BK * 2  , STAGE_BYTES = 8 * HTB, NXCD = 8, WGM = 8;

__host__ __device__ __forceinline__ int lds_byte(int r, int c) { const int st = (r >> 4) * 2 + (c >> 5), rr = r & 15, cc = c & 31, ob = rr * 64 + cc * 2; return st * 1024 + (ob ^ (((ob >> 9) & 1) << 5)); }
__host__ __device__ __forceinline__ void stage_rc(int b, int& R, int& C) { const int st = b / 1024, sb = b % 1024, swz = sb ^ (((sb >> 9) & 1) << 5); R = (st >> 1) * 16 + swz / 64; C = (st & 1) * 32 + (swz % 64) / 2; }
__host__ __device__ __forceinline__ int perm32(int rho) { const int n = rho >> 4, i = rho & 15; return 8 * (i >> 2) + 4 * n + (i & 3); }

struct Unit { int pm, pn; };
struct Gemm {
    const char* A; const char* B; int lda, ldb, K; size_t sAm, sAn, sBm, sBn;
    __device__ __forceinline__ const char* a_of(const Unit& u) const { return A + (size_t)u.pm * sAm + (size_t)u.pn * sAn; }
    __device__ __forceinline__ const char* b_of(const Unit& u) const { return B + (size_t)u.pm * sBm + (size_t)u.pn * sBn; }
};
__device__ __forceinline__ Gemm plain_gemm(const bf16_t* A, int lda, const bf16_t* Bt, int ldb, int K) {
    Gemm g; g.A = (const char*)A; g.B = (const char*)Bt; g.lda = lda; g.ldb = ldb; g.K = K;
    g.sAm = (size_t)BM * lda * 2; g.sAn = 0; g.sBm = 0; g.sBn = (size_t)BM * ldb * 2; return g;
}

struct StaticOrder {
    int nM, nN, nwg, G, c;
    __host__ __device__ void init(int M, int N, int G_, int c_) { nM = M / BM; nN = N / BM; nwg = nM * nN; G = G_; c = c_; }
    __host__ __device__ bool next(int i, Unit& u) const {
        const long L = (long)i * G + c; if (L >= nwg) return false;
        int wgid = (int)L; { const int q = nwg / NXCD, r = nwg % NXCD, xcd = wgid % NXCD, off = wgid / NXCD; wgid = (xcd < r ? xcd * (q + 1) : r * (q + 1) + (xcd - r) * q) + off; }
        const int nig = WGM * nN, gid = wgid / nig, fm = gid * WGM, gsz = (nM - fm) < WGM ? (nM - fm) : WGM;
        u.pm = fm + ((wgid % nig) % gsz); u.pn = (wgid % nig) / gsz; return true;
    }
    __device__ __forceinline__ void a_ready(const Unit&) const {}
    __device__ __forceinline__ void done(const Unit&) const {}
};

__device__ __forceinline__ f32x2 gelu_pk(f32x2 v) {
    const f32x2 av = __builtin_elementwise_abs(v), d = av * 0.2316418882f + 1.0f;
    f32x2 t; t.x = __builtin_amdgcn_rcpf(d.x); t.y = __builtin_amdgcn_rcpf(d.y);
    f32x2 q = t * 0.5307027145f + (-0.7265760135f); q = q * t + 0.7107068705f; q = q * t + (-0.142248368f); q = q * t + 0.127414796f; q = q * t;
    const f32x2 s = (v * v) * (-0.72134752044f);
    f32x2 e; e.x = __builtin_amdgcn_exp2f(s.x); e.y = __builtin_amdgcn_exp2f(s.y);
    const f32x2 m = v * (q * e), r = v - m;
    f32x2 o; o.x = v.x < 0.f ? m.x : r.x; o.y = v.y < 0.f ? m.y : r.y; return o;
}
__device__ __forceinline__ f32x4 act4(f32x4 v, int act) {
    if (act == 1) { f32x2 a = gelu_pk((f32x2){v[0], v[1]}), b = gelu_pk((f32x2){v[2], v[3]}); return (f32x4){a.x, a.y, b.x, b.y}; }
    if (act == 2) { f32x4 r; for (int i = 0; i < 4; ++i) { const float t = fmaxf(v[i], 0.f); r[i] = t * t; } return r; }
    return v;
}


template <int ACT> struct EpiBf16 {
    static constexpr bool PERM = true, AFTER_DRAIN = false;
    bf16_t* O; int ldc;
    __device__ __forceinline__ void operator()(const f32x4 (&acc)[2][2][4][2], const Unit& u, int wr, int wc, int fr, int fq) const {
        const int row0 = u.pm * BM + wr * 64 + fr, col0 = u.pn * BM + wc * 32 + 8 * fq;
#pragma unroll
        for (int ai = 0; ai < 2; ++ai)
#pragma unroll
            for (int m = 0; m < 4; ++m) { bf16_t* rowp = O + (size_t)(row0 + ai * HALF + m * 16) * ldc + col0;
#pragma unroll
                for (int bj = 0; bj < 2; ++bj) { const f32x4 v0 = act4(acc[ai][bj][m][0], ACT), v1 = act4(acc[ai][bj][m][1], ACT);
                    u32x4 w; w.x = cvt_pk_bf16(v0[0], v0[1]); w.y = cvt_pk_bf16(v0[2], v0[3]); w.z = cvt_pk_bf16(v1[0], v1[1]); w.w = cvt_pk_bf16(v1[2], v1[3]);
                    *(u32x4*)(rowp + bj * HALF) = w; } }
    }
};
struct EpiF32 {
    static constexpr bool PERM = false, AFTER_DRAIN = false;
    float* O; int ldc;
    __device__ __forceinline__ void operator()(const f32x4 (&acc)[2][2][4][2], const Unit& u, int wr, int wc, int fr, int fq) const {
        const int row0 = u.pm * BM + wr * 64 + fr, col0 = u.pn * BM + wc * 32 + 4 * fq;
#pragma unroll
        for (int ai = 0; ai < 2; ++ai)
#pragma unroll
            for (int m = 0; m < 4; ++m) { float* rowp = O + (size_t)(row0 + ai * HALF + m * 16) * ldc + col0;
#pragma unroll
                for (int bj = 0; bj < 2; ++bj)
#pragma unroll
                    for (int n = 0; n < 2; ++n) *(f32x4*)(rowp + bj * HALF + n * 16) = acc[ai][bj][m][n]; }
    }
};
struct EpiResid {
    static constexpr bool PERM = false, AFTER_DRAIN = false;
    const float* srcLat; const float* srcCtx; float* dstLat; float* dstCtx; const float* gate;
    __device__ __forceinline__ void operator()(const f32x4 (&acc)[2][2][4][2], const Unit& u, int wr, int wc, int fr, int fq) const {
        const bool lat = u.pm < MLAT / BM;
        const int rbase = lat ? u.pm * BM : u.pm * BM - MLAT, bidx = lat ? (u.pm >> 4) : 4;
        const float* src = lat ? srcLat : srcCtx; float* dst = lat ? dstLat : dstCtx;
        const int row0 = rbase + wr * 64 + fr, col0 = u.pn * BM + wc * 32 + 4 * fq;
        const float* gp = gate + (size_t)bidx * NMOD + col0;
        f32x4 gv[2][2];
#pragma unroll
        for (int bj = 0; bj < 2; ++bj)
#pragma unroll
            for (int n = 0; n < 2; ++n) gv[bj][n] = *(const f32x4*)(gp + bj * HALF + n * 16);
#pragma unroll
        for (int ai = 0; ai < 2; ++ai)
#pragma unroll
            for (int m = 0; m < 4; ++m) { const size_t off = (size_t)(row0 + ai * HALF + m * 16) * DM + col0;
#pragma unroll
                for (int bj = 0; bj < 2; ++bj)
#pragma unroll
                    for (int n = 0; n < 2; ++n) { const f32x4 s = *(const f32x4*)(src + off + bj * HALF + n * 16);
                        *(f32x4*)(dst + off + bj * HALF + n * 16) = s + gv[bj][n] * acc[ai][bj][m][n]; } }
    }
};
struct EpiGeluT {
    static constexpr bool PERM = true, AFTER_DRAIN = false;
    bf16_t* O; int ldc; float* S1; float* S2;
    __device__ __forceinline__ void operator()(const f32x4 (&acc)[2][2][4][2], const Unit& u, int wr, int wc, int fr, int fq) const {
        const int row0 = u.pm * BM + wr * 64 + fr, col0 = u.pn * BM + wc * 32 + 8 * fq;
        f32x4 s1[2][2], s2[2][2];
#pragma unroll
        for (int bj = 0; bj < 2; ++bj)
#pragma unroll
            for (int n = 0; n < 2; ++n) { s1[bj][n] = (f32x4){0.f, 0.f, 0.f, 0.f}; s2[bj][n] = (f32x4){0.f, 0.f, 0.f, 0.f}; }
#pragma unroll
        for (int ai = 0; ai < 2; ++ai)
#pragma unroll
            for (int m = 0; m < 4; ++m) { bf16_t* rowp = O + (size_t)(row0 + ai * HALF + m * 16) * ldc + col0;
#pragma unroll
                for (int bj = 0; bj < 2; ++bj) { const f32x4 v0 = act4(acc[ai][bj][m][0], 1), v1 = act4(acc[ai][bj][m][1], 1);
                    s1[bj][0] += v0; s1[bj][1] += v1; s2[bj][0] += v0 * v0; s2[bj][1] += v1 * v1;
                    u32x4 w; w.x = cvt_pk_bf16(v0[0], v0[1]); w.y = cvt_pk_bf16(v0[2], v0[3]); w.z = cvt_pk_bf16(v1[0], v1[1]); w.w = cvt_pk_bf16(v1[2], v1[3]);
                    *(u32x4*)(rowp + bj * HALF) = w; } }
#pragma unroll
        for (int bj = 0; bj < 2; ++bj)
#pragma unroll
            for (int n = 0; n < 2; ++n)
#pragma unroll
                for (int e = 0; e < 4; ++e) { float a = s1[bj][n][e], b = s2[bj][n][e];
#pragma unroll
                    for (int o = 1; o < 16; o <<= 1) { a += __shfl_xor(a, o); b += __shfl_xor(b, o); }
                    if (fr == 0) { const int col = col0 + bj * HALF + n * 4 + e; atomicAdd(S1 + col, a); atomicAdd(S2 + col, b); } }
    }
};
struct EpiGate {
    static constexpr bool PERM = true, AFTER_DRAIN = false;
    bf16_t* U; int ldc; const float* bs;
    __device__ __forceinline__ void operator()(const f32x4 (&acc)[2][2][4][2], const Unit& u, int wr, int wc, int fr, int fq) const {
        const int row0 = u.pm * BM + wr * 64 + fr, col0 = u.pn * BM + wc * 32 + 8 * fq;
#pragma unroll
        for (int ai = 0; ai < 2; ++ai)
#pragma unroll
            for (int m = 0; m < 4; ++m) { const int row = row0 + ai * HALF + m * 16; const float bias = bs[u.pn * 128 + (row & 127)];
                bf16_t* rowp = U + (size_t)row * ldc + col0;
#pragma unroll
                for (int bj = 0; bj < 2; ++bj) { const u32x4 uu = *(const u32x4*)(rowp + bj * HALF);
                    const f32x4 a0 = acc[ai][bj][m][0] + bias, a1 = acc[ai][bj][m][1] + bias;
                    u32x4 w; w.x = cvt_pk_bf16(bf_lo(uu.x) * a0[0], bf_hi(uu.x) * a0[1]); w.y = cvt_pk_bf16(bf_lo(uu.y) * a0[2], bf_hi(uu.y) * a0[3]);
                    w.z = cvt_pk_bf16(bf_lo(uu.z) * a1[0], bf_hi(uu.z) * a1[1]); w.w = cvt_pk_bf16(bf_lo(uu.w) * a1[2], bf_hi(uu.w) * a1[3]);
                    *(u32x4*)(rowp + bj * HALF) = w; } }
    }
};

template <class Epi, class Sched, bool ALIGN_EPI = false, bool SP2 = false>
__device__ __forceinline__ void gemm_phase(PG8_LAS unsigned char* lds, const Gemm g, const Sched& S, const Epi& E) {
    int tid_ = threadIdx.x; asm volatile("" : "+v"(tid_));
    const int tid = tid_, wid = __builtin_amdgcn_readfirstlane(tid >> 6), lane = tid & 63, wr = wid >> 2, wc = wid & 3, fr = lane & 15, fq = lane >> 4;
    const int K = g.K, nt = K / BK;
    unsigned voffA[2], voffB[2];
#pragma unroll
    for (int i = 0; i < 2; ++i) { int R, C; stage_rc(tid * 16 + i * 8192, R, C); const int Rb = Epi::PERM ? ((R & ~31) + perm32(R & 31)) : R;
        voffA[i] = (unsigned)(R * g.lda + C) * 2u; voffB[i] = (unsigned)(Rb * g.ldb + C) * 2u; }
    const size_t kstep = (size_t)(BK * 2);
    const size_t hstepA = (size_t)HALF * g.lda * 2, hstepB = (size_t)HALF * g.ldb * 2;
    const unsigned ldsw = (unsigned)wid * 1024u;
    const int aoff = lds_byte(wr * 64 + fr, fq * 8), boff = lds_byte(wc * 32 + fr, fq * 8);
#define PG8_SA(b, h) (((b) * 2 + (h)) * HTB)
#define PG8_SB(b, h) ((4 + (b) * 2 + (h)) * HTB)
#define PG8_STAGE(bufoff, gbase, voff) do { _Pragma("unroll") for (int _i = 0; _i < 2; ++_i) \
        __builtin_amdgcn_global_load_lds((const unsigned*)((const char*)(gbase) + (voff)[_i]), (PG8_LAS unsigned*)(lds + (bufoff) + ldsw + _i * 8192), 16, 0, 0); } while (0)
#define PG8_LDA(dst, b, h) do { _Pragma("unroll") for (int m = 0; m < 4; ++m) _Pragma("unroll") for (int k = 0; k < 2; ++k) dst[m][k] = *(const PG8_LAS bf16x8*)(lds + PG8_SA(b, h) + aoff + m * 2048 + k * 1024); } while (0)
#define PG8_LDB(dst, b, h) do { _Pragma("unroll") for (int n = 0; n < 2; ++n) _Pragma("unroll") for (int k = 0; k < 2; ++k) dst[n][k] = *(const PG8_LAS bf16x8*)(lds + PG8_SB(b, h) + boff + n * 2048 + k * 1024); } while (0)
#define PG8_MMA(ai, bj, At, Bt) do { __builtin_amdgcn_s_setprio(1); _Pragma("unroll") for (int m = 0; m < 4; ++m) _Pragma("unroll") for (int n = 0; n < 2; ++n) _Pragma("unroll") for (int k = 0; k < 2; ++k) \
        acc[ai][bj][m][n] = __builtin_amdgcn_mfma_f32_16x16x32_bf16(Bt[n][k], At[m][k], acc[ai][bj][m][n], 0, 0, 0); __builtin_amdgcn_s_setprio(0); } while (0)
#define PG8_WAIT_V(n) asm volatile("s_waitcnt vmcnt(" #n ")" ::: "memory")
#define PG8_WAIT_L(n) asm volatile("s_waitcnt lgkmcnt(" #n ")" ::: "memory")
#define PG8_BAR __builtin_amdgcn_s_barrier()
#define PG8_SCHED __builtin_amdgcn_sched_barrier(0)
    Unit cur, nxt; int ui = 0;
    if (!S.next(0, cur)) return;
    f32x4 acc[2][2][4][2];
#pragma unroll
    for (int a = 0; a < 2; ++a)
#pragma unroll
        for (int b = 0; b < 2; ++b)
#pragma unroll
            for (int m = 0; m < 4; ++m)
#pragma unroll
                for (int n = 0; n < 2; ++n) acc[a][b][m][n] = (f32x4){0.f, 0.f, 0.f, 0.f};
    bf16x8 At[4][2], B0[2][2], B1[2][2];
    const char* cA = g.a_of(cur); const char* cB = g.b_of(cur);
    S.a_ready(cur);
    if constexpr (SP2) {
        PG8_STAGE(PG8_SB(0, 0), cB, voffB); PG8_STAGE(PG8_SB(0, 1), cB + hstepB, voffB); PG8_STAGE(PG8_SA(0, 0), cA, voffA); PG8_STAGE(PG8_SA(0, 1), cA + hstepA, voffA);
        if (wr == 1) PG8_BAR;
        PG8_WAIT_V(2); PG8_BAR;
        PG8_STAGE(PG8_SB(1, 0), cB + kstep, voffB); PG8_STAGE(PG8_SA(1, 0), cA + kstep, voffA); PG8_STAGE(PG8_SB(1, 1), cB + hstepB + kstep, voffB);
        PG8_WAIT_V(6); PG8_BAR;
    } else {
        PG8_STAGE(PG8_SB(0, 0), cB, voffB); PG8_STAGE(PG8_SA(0, 0), cA, voffA); PG8_STAGE(PG8_SB(0, 1), cB + hstepB, voffB); PG8_STAGE(PG8_SA(0, 1), cA + hstepA, voffA);
        if (wr == 1) PG8_BAR;
        PG8_WAIT_V(4); PG8_BAR;
        PG8_STAGE(PG8_SB(1, 0), cB + kstep, voffB); PG8_STAGE(PG8_SA(1, 0), cA + kstep, voffA); PG8_STAGE(PG8_SB(1, 1), cB + hstepB + kstep, voffB);
        PG8_WAIT_V(6); PG8_BAR;
    }
    for (;;) {
        const bool has_next = S.next(ui + 1, nxt);
        const char* nA = has_next ? g.a_of(nxt) : cA; const char* nB = has_next ? g.b_of(nxt) : cB;
        for (int t = 0; t < nt; t += 2) {
            const bool last = (t == nt - 2);
            const char* a1 = cA + (size_t)(t + 1) * kstep;
            const char* a2 = last ? nA : cA + (size_t)(t + 2) * kstep; const char* b2 = last ? nB : cB + (size_t)(t + 2) * kstep;
            const char* a3 = a2 + kstep; const char* b3 = b2 + kstep;
            if (last && has_next) S.a_ready(nxt);
            if constexpr (SP2) {
            PG8_LDB(B0, 0, 0); PG8_LDB(B1, 0, 1); PG8_SCHED; PG8_LDA(At, 0, 0); PG8_STAGE(PG8_SA(1, 1), a1 + hstepA, voffA);
            PG8_WAIT_V(8); PG8_WAIT_L(0); PG8_BAR; PG8_MMA(0, 0, At, B0); PG8_MMA(0, 1, At, B1); PG8_BAR; PG8_SCHED;
            PG8_LDA(At, 0, 1); PG8_STAGE(PG8_SB(0, 0), b2, voffB); PG8_STAGE(PG8_SB(0, 1), b2 + hstepB, voffB); PG8_STAGE(PG8_SA(0, 0), a2, voffA);
            PG8_WAIT_V(8); PG8_WAIT_L(0); PG8_BAR; PG8_MMA(1, 0, At, B0); PG8_MMA(1, 1, At, B1); PG8_BAR; PG8_SCHED;
            PG8_LDB(B0, 1, 0); PG8_LDB(B1, 1, 1); PG8_SCHED; PG8_LDA(At, 1, 0); PG8_STAGE(PG8_SA(0, 1), a2 + hstepA, voffA);
            PG8_WAIT_V(8); PG8_WAIT_L(0); PG8_BAR; PG8_MMA(0, 0, At, B0); PG8_MMA(0, 1, At, B1); PG8_BAR; PG8_SCHED;
            PG8_LDA(At, 1, 1); PG8_STAGE(PG8_SB(1, 0), b3, voffB); PG8_STAGE(PG8_SB(1, 1), b3 + hstepB, voffB); PG8_STAGE(PG8_SA(1, 0), a3, voffA);
            PG8_WAIT_V(8); PG8_WAIT_L(0); PG8_BAR; PG8_MMA(1, 0, At, B0); PG8_MMA(1, 1, At, B1); PG8_BAR; PG8_SCHED;
            } else {
            PG8_LDB(B0, 0, 0); PG8_SCHED; PG8_LDA(At, 0, 0); PG8_STAGE(PG8_SA(1, 1), a1 + hstepA, voffA);
            PG8_WAIT_L(8); PG8_BAR; PG8_WAIT_L(0); PG8_MMA(0, 0, At, B0); PG8_BAR; PG8_SCHED;
            PG8_LDB(B1, 0, 1); PG8_STAGE(PG8_SB(0, 0), b2, voffB);
            PG8_BAR; PG8_WAIT_L(0); PG8_MMA(0, 1, At, B1); PG8_BAR;
            PG8_LDA(At, 0, 1); PG8_STAGE(PG8_SA(0, 0), a2, voffA);
            PG8_BAR; PG8_WAIT_L(0); PG8_MMA(1, 0, At, B0); PG8_BAR; PG8_SCHED;
            PG8_STAGE(PG8_SB(0, 1), b2 + hstepB, voffB);
            PG8_WAIT_V(6); PG8_BAR; PG8_MMA(1, 1, At, B1); PG8_BAR;
            PG8_LDB(B0, 1, 0); PG8_SCHED; PG8_LDA(At, 1, 0); PG8_STAGE(PG8_SA(0, 1), a2 + hstepA, voffA);
            PG8_WAIT_L(8); PG8_BAR; PG8_WAIT_L(0); PG8_MMA(0, 0, At, B0); PG8_BAR; PG8_SCHED;
            PG8_LDB(B1, 1, 1); PG8_STAGE(PG8_SB(1, 0), b3, voffB);
            PG8_BAR; PG8_WAIT_L(0); PG8_MMA(0, 1, At, B1); PG8_BAR;
            PG8_LDA(At, 1, 1); PG8_STAGE(PG8_SA(1, 0), a3, voffA);
            PG8_BAR; PG8_WAIT_L(0); PG8_MMA(1, 0, At, B0); PG8_BAR; PG8_SCHED;
            PG8_STAGE(PG8_SB(1, 1), b3 + hstepB, voffB);
            PG8_WAIT_V(6); PG8_BAR; PG8_MMA(1, 1, At, B1); PG8_BAR;
            }
        }
        if constexpr (ALIGN_EPI) { if (wr == 0) PG8_BAR; }
        if constexpr (!Epi::AFTER_DRAIN) { E(acc, cur, wr, wc, fr, fq); S.done(cur); }
        if (!has_next) break;
#pragma unroll
        for (int a = 0; a < 2; ++a)
#pragma unroll
            for (int b = 0; b < 2; ++b)
#pragma unroll
                for (int m = 0; m < 4; ++m)
#pragma unroll
                    for (int n = 0; n < 2; ++n) acc[a][b][m][n] = (f32x4){0.f, 0.f, 0.f, 0.f};
        cur = nxt; cA = nA; cB = nB; ++ui;
        if constexpr (ALIGN_EPI) { if (wr == 1) PG8_BAR; }
    }
    PG8_WAIT_V(0);
    if constexpr (!ALIGN_EPI) { if (wr == 0) PG8_BAR; }
    PG8_BAR;
    if constexpr (Epi::AFTER_DRAIN) { E.fused(acc, cur, wr, wc, fr, fq, lds, wid, lane); S.done(cur); }
#undef PG8_SA
#undef PG8_SB
#undef PG8_STAGE
#undef PG8_LDA
#undef PG8_LDB
#undef PG8_MMA
#undef PG8_WAIT_V
#undef PG8_WAIT_L
#undef PG8_BAR
#undef PG8_SCHED
}
}

namespace att {
using f32x16 = __attribute__((ext_vector_type(16))) float;
using s16x4  = __attribute__((ext_vector_type(4))) short;
constexpr int NW = 8, QBLK = 32, KVBLK = 64;
constexpr float SCALE = 0.072168783648703220f;
constexpr float THR = 8.f;
constexpr int LDQ = NH * QKD, LDKV = NH * 256, LDKP = NH * QKR, LDO = NH * VD;
constexpr int SHM_V = KVBLK * 128 * 2, SHM_KN = KVBLK * 128 * 2, SHM_KP = KVBLK * 64 * 2;
constexpr int OFF_V = 0, OFF_KN = 2 * SHM_V, OFF_KP = OFF_KN + 2 * SHM_KN, OFF_WS = OFF_KP + 2 * SHM_KP, SHM_ATTN = OFF_WS + NW * 64 * 4;
#define KSWZ(row, colB) ((row) * 256 + ((colB) ^ (((row) & 7) << 4)))
#define KPSWZ(row, colB) ((row) * 128 + ((colB) ^ (((row) & 7) << 4)))
#define SBAR() __builtin_amdgcn_sched_barrier(0)
__device__ __forceinline__ int crow(int r, int hi) { return (r & 3) + 8 * (r >> 2) + 4 * hi; }
__device__ __forceinline__ unsigned cvtpk(float lo, float hi) { unsigned r; asm volatile("v_cvt_pk_bf16_f32 %0, %1, %2" : "=v"(r) : "v"(lo), "v"(hi)); return r; }
__device__ __forceinline__ bf16x8 ld8(const bf16_t* p) { return *reinterpret_cast<const bf16x8*>(p); }

__device__ __forceinline__ void partialSM(f32x16& p0, f32x16& p1, float& m_reg, float& mn, float& alpha) {
  constexpr float C = SCALE * 1.4426950408889634f;
  float pmax = p0[0]; for (int r = 1; r < 16; ++r) pmax = fmaxf(pmax, p0[r]); for (int r = 0; r < 16; ++r) pmax = fmaxf(pmax, p1[r]);
  { auto rr = __builtin_amdgcn_permlane32_swap(__float_as_uint(pmax), __float_as_uint(pmax), false, false);
    pmax = fmaxf(__uint_as_float(rr[0]), __uint_as_float(rr[1])); }
  if (__builtin_expect(__all(pmax - m_reg <= THR / SCALE), 1)) { mn = m_reg; alpha = 1.f; }
  else { mn = fmaxf(m_reg, pmax); alpha = __builtin_amdgcn_exp2f((m_reg - mn) * C); m_reg = mn; }
  float mnC = -mn * C;
  for (int r = 0; r < 16; ++r) p0[r] = fmaf(p0[r], C, mnC); for (int r = 0; r < 16; ++r) p1[r] = fmaf(p1[r], C, mnC);
  for (int r = 0; r < 16; ++r) p0[r] = __builtin_amdgcn_exp2f(p0[r]);
}
__device__ __forceinline__ void finishSM(f32x16& p0, f32x16& p1, float alpha, float& l_reg, bf16x8& pa0, bf16x8& pa1, bf16x8& pa2, bf16x8& pa3) {
  for (int r = 0; r < 16; ++r) p1[r] = __builtin_amdgcn_exp2f(p1[r]);
  float ps = 0; for (int r = 0; r < 16; ++r) ps += p0[r]; for (int r = 0; r < 16; ++r) ps += p1[r];
  { auto rr = __builtin_amdgcn_permlane32_swap(__float_as_uint(ps), __float_as_uint(ps), false, false);
    ps = __uint_as_float(rr[0]) + __uint_as_float(rr[1]); }
  l_reg = l_reg * alpha + ps;
#define PK4(P, BASE, OUT) do { unsigned a0 = cvtpk(P[BASE + 0], P[BASE + 1]), a1 = cvtpk(P[BASE + 2], P[BASE + 3]);   \
    unsigned b0 = cvtpk(P[BASE + 4], P[BASE + 5]), b1 = cvtpk(P[BASE + 6], P[BASE + 7]);                              \
    auto r0 = __builtin_amdgcn_permlane32_swap(a0, b0, false, false); auto r1 = __builtin_amdgcn_permlane32_swap(a1, b1, false, false); \
    u32x4 w = {r0[0], r1[0], r0[1], r1[1]}; OUT = *reinterpret_cast<bf16x8*>(&w); } while (0)
  PK4(p0, 0, pa0); PK4(p0, 8, pa1); PK4(p1, 0, pa2); PK4(p1, 8, pa3);
#undef PK4
}
__device__ __forceinline__ void qkt(f32x16& p0, f32x16& p1, const char* Kn, const char* Kp, const bf16x8* qr, int r32, int hi) {
  p0 = f32x16{}; p1 = f32x16{};
#pragma unroll
  for (int d0 = 0; d0 < 8; ++d0) { int cb = (d0 * 16 + hi * 8) * 2;
    bf16x8 b0 = *reinterpret_cast<const bf16x8*>(Kn + KSWZ(r32, cb));
    bf16x8 b1 = *reinterpret_cast<const bf16x8*>(Kn + KSWZ(32 + r32, cb));
    p0 = __builtin_amdgcn_mfma_f32_32x32x16_bf16(b0, qr[d0], p0, 0, 0, 0);
    p1 = __builtin_amdgcn_mfma_f32_32x32x16_bf16(b1, qr[d0], p1, 0, 0, 0); }
#pragma unroll
  for (int d1 = 0; d1 < 4; ++d1) { int cb = (d1 * 16 + hi * 8) * 2;
    bf16x8 b0 = *reinterpret_cast<const bf16x8*>(Kp + KPSWZ(r32, cb));
    bf16x8 b1 = *reinterpret_cast<const bf16x8*>(Kp + KPSWZ(32 + r32, cb));
    p0 = __builtin_amdgcn_mfma_f32_32x32x16_bf16(b0, qr[8 + d1], p0, 0, 0, 0);
    p1 = __builtin_amdgcn_mfma_f32_32x32x16_bf16(b1, qr[8 + d1], p1, 0, 0, 0); }
}
__device__ __forceinline__ int v_st(int k, int c) { const int kk = (k & ~0xC) | ((k & 4) << 1) | ((k & 8) >> 1); return ((kk >> 3) * 4 + (c >> 5)) * 512 + ((kk & 7) * 32 + (c & 31)) * 2; }
__device__ __forceinline__ int v_rd_base(int lane) { return ((lane & 3) << 3) | (((lane >> 2) & 3) << 6) | (((lane >> 4) & 1) << 5) | (((lane >> 5) & 1) << 8); }
constexpr int v_rd_off(int d0, int ks, int half) { return d0 * 512 + ks * 4096 + half * 2048; }
template <int OFF> __device__ __forceinline__ s16x4 tr_read(int vb) {
  s16x4 r; asm volatile("ds_read_b64_tr_b16 %0, %1 offset:%2" : "=&v"(r) : "v"(vb), "i"(OFF) : "memory"); return r;
}
template <int D0> __device__ __forceinline__ void pv_one(f32x16& od, int vb, bf16x8 pa0, bf16x8 pa1, bf16x8 pa2, bf16x8 pa3) {
  const s16x4 l0 = tr_read<v_rd_off(D0, 0, 0)>(vb), h0 = tr_read<v_rd_off(D0, 0, 1)>(vb), l1 = tr_read<v_rd_off(D0, 1, 0)>(vb), h1 = tr_read<v_rd_off(D0, 1, 1)>(vb);
  const s16x4 l2 = tr_read<v_rd_off(D0, 2, 0)>(vb), h2 = tr_read<v_rd_off(D0, 2, 1)>(vb), l3 = tr_read<v_rd_off(D0, 3, 0)>(vb), h3 = tr_read<v_rd_off(D0, 3, 1)>(vb);
  asm volatile("s_waitcnt lgkmcnt(0)" ::: "memory"); SBAR();
#define PK(L, H) (bf16x8){L[0], L[1], L[2], L[3], H[0], H[1], H[2], H[3]}
  od = __builtin_amdgcn_mfma_f32_32x32x16_bf16(pa0, PK(l0, h0), od, 0, 0, 0);
  od = __builtin_amdgcn_mfma_f32_32x32x16_bf16(pa1, PK(l1, h1), od, 0, 0, 0);
  od = __builtin_amdgcn_mfma_f32_32x32x16_bf16(pa2, PK(l2, h2), od, 0, 0, 0);
  od = __builtin_amdgcn_mfma_f32_32x32x16_bf16(pa3, PK(l3, h3), od, 0, 0, 0);
#undef PK
}
__device__ __forceinline__ void pv_d0(f32x16* o, int vb, bf16x8 pa0, bf16x8 pa1, bf16x8 pa2, bf16x8 pa3) {
  pv_one<0>(o[0], vb, pa0, pa1, pa2, pa3); pv_one<1>(o[1], vb, pa0, pa1, pa2, pa3); pv_one<2>(o[2], vb, pa0, pa1, pa2, pa3); pv_one<3>(o[3], vb, pa0, pa1, pa2, pa3);
}

__device__ __forceinline__ void attn_unit(const bf16_t* __restrict__ Qb, const bf16_t* __restrict__ KV, const bf16_t* __restrict__ KP, bf16_t* __restrict__ Ob,
                                          int h, int qrow0, int ctx0, int lat0, int NT, char* lds) {
  int tid_ = threadIdx.x; asm volatile("" : "+v"(tid_));
  const int tid = tid_, wid = tid >> 6, lane = tid & 63, r32 = lane & 31, hi = lane >> 5;
  char* V_lds = lds + OFF_V; char* KN_lds = lds + OFF_KN; char* KP_lds = lds + OFF_KP;
  float* ws = (float*)(lds + OFF_WS) + wid * 64; float* li_l = ws; float* al_l = ws + 32;
  float m_reg = -1e30f, l_reg = 0; f32x16 o[4] = {}; bf16x8 qr[12];
  const bf16_t* Qw = Qb + (size_t)(qrow0 + wid * QBLK + r32) * LDQ + h * QKD + hi * 8;
#pragma unroll
  for (int d0 = 0; d0 < 12; ++d0) qr[d0] = ld8(Qw + d0 * 16);
  const int sr = tid >> 4, sc = (tid & 15) * 8, vst0 = v_st(sr, sc), vst1 = v_st(32 + sr, sc);
  const int pr = tid >> 3, pc = (tid & 7) * 8;
  const int vb0 = (int)(uintptr_t)V_lds + v_rd_base(lane);
  bf16x8 vs0, vs1, ks0, ks1, kp0;
  const bf16_t* KVh = KV + h * 256; const bf16_t* KPh = KP + h * QKR;
#define TROW(j) ((j) < 4 ? ctx0 + (j) * KVBLK : lat0 + ((j) - 4) * KVBLK)
#define SLOAD(j) do { const int r0_ = TROW(j); const bf16_t* a_ = KVh + (size_t)(r0_ + sr) * LDKV + sc; const bf16_t* b_ = KVh + (size_t)(r0_ + 32 + sr) * LDKV + sc; \
    vs0 = ld8(a_ + 128); vs1 = ld8(b_ + 128); ks0 = ld8(a_); ks1 = ld8(b_); kp0 = ld8(KPh + (size_t)(r0_ + pr) * LDKP + pc); } while (0)
#define SWRITE(b) do { *(bf16x8*)(V_lds + (b) * SHM_V + vst0) = vs0; *(bf16x8*)(V_lds + (b) * SHM_V + vst1) = vs1; const int kc = sc * 2; \
    *(bf16x8*)(KN_lds + (b) * SHM_KN + KSWZ(sr, kc)) = ks0; *(bf16x8*)(KN_lds + (b) * SHM_KN + KSWZ(32 + sr, kc)) = ks1; \
    *(bf16x8*)(KP_lds + (b) * SHM_KP + KPSWZ(pr, pc * 2)) = kp0; } while (0)
#define SWAIT() asm volatile("s_waitcnt vmcnt(0)" ::: "memory")
#define RESC(a) do { if (__any((a) < 1.f)) { if (hi == 0) al_l[r32] = (a); asm volatile("s_waitcnt lgkmcnt(0)" ::: "memory"); \
    for (int d = 0; d < 4; ++d) for (int r = 0; r < 16; ++r) o[d][r] *= al_l[crow(r, hi)]; } } while (0)
  f32x16 pA0, pA1, pB0, pB1; float mnA, mnB, alA, alB; bf16x8 pa0, pa1, pa2, pa3;
  SLOAD(0); SWAIT(); SWRITE(0); __syncthreads();
  qkt(pA0, pA1, KN_lds, KP_lds, qr, r32, hi); partialSM(pA0, pA1, m_reg, mnA, alA);
  SLOAD(1);
  SWAIT(); SWRITE(1); __syncthreads();
  for (int j = 1; j + 1 < NT; j += 2) {
    SBAR(); qkt(pB0, pB1, KN_lds + SHM_KN, KP_lds + SHM_KP, qr, r32, hi);
    finishSM(pA0, pA1, alA, l_reg, pa0, pa1, pa2, pa3); SBAR();
    SLOAD(j + 1); SBAR();
    pv_d0(o, vb0, pa0, pa1, pa2, pa3); partialSM(pB0, pB1, m_reg, mnB, alB);
    __syncthreads(); SWAIT(); SWRITE(0);
    RESC(alB); __syncthreads();
    SBAR(); qkt(pA0, pA1, KN_lds, KP_lds, qr, r32, hi);
    finishSM(pB0, pB1, alB, l_reg, pa0, pa1, pa2, pa3); SBAR();
    SLOAD(j + 2); SBAR();
    pv_d0(o, vb0 + SHM_V, pa0, pa1, pa2, pa3); partialSM(pA0, pA1, m_reg, mnA, alA);
    __syncthreads(); SWAIT(); SWRITE(1);
    RESC(alA); __syncthreads();
  }
  SBAR(); qkt(pB0, pB1, KN_lds + SHM_KN, KP_lds + SHM_KP, qr, r32, hi);
  finishSM(pA0, pA1, alA, l_reg, pa0, pa1, pa2, pa3); SBAR();
  pv_d0(o, vb0, pa0, pa1, pa2, pa3); partialSM(pB0, pB1, m_reg, mnB, alB);
  __syncthreads(); RESC(alB);
  finishSM(pB0, pB1, alB, l_reg, pa0, pa1, pa2, pa3); SBAR();
  pv_d0(o, vb0 + SHM_V, pa0, pa1, pa2, pa3);
  if (hi == 0) li_l[r32] = l_reg; asm volatile("s_waitcnt lgkmcnt(0)" ::: "memory");
  float rli[16];
#pragma unroll
  for (int r = 0; r < 16; ++r) rli[r] = __builtin_amdgcn_rcpf(li_l[crow(r, hi)]);
  bf16_t* Ow = Ob + (size_t)(qrow0 + wid * QBLK) * LDO + h * VD;
#pragma unroll
  for (int r = 0; r < 16; ++r) { const int orow = crow(r, hi);
#pragma unroll
    for (int d0 = 0; d0 < 4; ++d0) { const float v = o[d0][r] * rli[r]; Ow[(size_t)orow * LDO + d0 * 32 + r32] = (bf16_t)(cvtpk(v, v) & 0xffffu); } }
  __syncthreads();
#undef TROW
#undef SLOAD
#undef SWRITE
#undef SWAIT
#undef RESC
}
#undef SBAR
}

constexpr size_t MiB = 1u << 20;
constexpr size_t WS_CTL = 0;
constexpr size_t WS_MOD = 1 * MiB;
constexpr size_t WS_ROPE = WS_MOD + 512 * 1024;
constexpr size_t WS_STAT = 2 * MiB;
constexpr size_t WS_XC = 3 * MiB;
constexpr size_t WS_W = 8 * MiB;
constexpr size_t WS_W1 = WS_W, WS_W2 = WS_W + 8 * MiB, W_FFN_STRIDE = 16 * MiB;
constexpr size_t WS_MLA = WS_W + 64 * MiB, W_MLA_STRIDE = 6 * MiB;
constexpr size_t OFF_WQKVA = 0, OFF_WQB = 3 * MiB / 2, OFF_WKVB = 11 * MiB / 4, OFF_WO = 4 * MiB;
constexpr size_t WS_GM = WS_MLA + 2 * W_MLA_STRIDE, W_GM_STRIDE = 13 * MiB;
constexpr size_t OFF_WIN = 0, OFF_WOUT = 8 * MiB, OFF_WBLK = 12 * MiB;
constexpr size_t WS_H = WS_GM + 2 * W_GM_STRIDE;
constexpr size_t WS_QKVA = WS_H + 34 * MiB;
constexpr size_t WS_CQ = WS_QKVA + 51 * MiB;
constexpr size_t WS_CKV = WS_CQ + 13 * MiB;
constexpr size_t WS_BIG = WS_CKV + 9 * MiB;
constexpr size_t OFF_QRAW = 0, OFF_KVRAW = 51 * MiB, OFF_KPE = 119 * MiB;
constexpr size_t OFF_FFH = 0;
constexpr size_t OFF_GU = 0, OFF_GVT = 68 * MiB;
constexpr size_t WS_END = WS_BIG + 136 * MiB;
static_assert(WS_H == 110 * MiB && WS_END == 353 * MiB, "ws map");

constexpr int LDS_BYTES = 147456;
static_assert(att::SHM_ATTN <= pg8::STAGE_BYTES, "attention LDS fits the GEMM ring");

struct Args { const float* in[25]; float* out; unsigned char* ws; int ph_lo, ph_hi; };
enum { I_X = 0, I_C, I_CTX, I_CCTX, I_ADAW, I_ADAB, I_NMG, I_NFG, I_WQA, I_QAN, I_WQB, I_WKVA, I_KVAN, I_WKVB, I_QN, I_KN, I_WO,
       I_GWIN, I_GLNG, I_GLNB, I_GWS, I_GBS, I_GWOUT, I_W1, I_W2 };

__device__ __forceinline__ unsigned f2bf(float f) { unsigned u = __builtin_bit_cast(unsigned, f); return (u + 0x7fffu + ((u >> 16) & 1u)) >> 16; }
__device__ __forceinline__ unsigned pk2(float lo, float hi) { return f2bf(lo) | (f2bf(hi) << 16); }

__device__ __forceinline__ void p0_transpose_item(const float* W, int K, int N, bf16_t* WT, int row_off, LAS float* scr, int item, int lane) {
    const int nblk = N / 32, kb = item / nblk, nb = item % nblk, k0 = 64 * kb, n0 = 32 * nb;
#pragma unroll 8
    for (int i = 0; i < 32; ++i) { const int kk = 2 * i + (lane >> 5); scr[kk * 33 + (lane & 31)] = W[(size_t)(k0 + kk) * N + n0 + (lane & 31)]; }
    asm volatile("s_waitcnt lgkmcnt(0)" ::: "memory");
    const int c = lane & 7;
#pragma unroll
    for (int j = 0; j < 4; ++j) { const int n = (lane >> 3) + 8 * j; const LAS float* s = scr + (8 * c) * 33 + n;
        u32x4 o; o.x = pk2(s[0 * 33], s[1 * 33]); o.y = pk2(s[2 * 33], s[3 * 33]); o.z = pk2(s[4 * 33], s[5 * 33]); o.w = pk2(s[6 * 33], s[7 * 33]);
        *(u32x4*)(WT + (size_t)(row_off + n0 + n) * K + k0 + 8 * c) = o; }
    asm volatile("s_waitcnt lgkmcnt(0)" ::: "memory");
}

__device__ __forceinline__ void p0_phase(const Args& a, unsigned char* ws, LAS unsigned char* lds, int bx, int G, int tid, int wave, int lane) {
    LAS float* sil = (LAS float*)lds;
    LAS float* red = (LAS float*)(lds + 20480);
    for (int it = bx; it < 4 * 24; it += G) {
        const int l = it / 24, cg_ = it % 24, col0 = cg_ * 256;
        for (int i = tid; i < 5 * 1024; i += 512) { const int b = i >> 10, k = i & 1023; const float v = b < 4 ? a.in[I_C][b * 1024 + k] : a.in[I_CCTX][k]; sil[i] = v / (1.f + __expf(-v)); }
        __syncthreads();
        f32x4 acc[5];
#pragma unroll
        for (int b = 0; b < 5; ++b) acc[b] = (f32x4){0.f, 0.f, 0.f, 0.f};
        const float* W = a.in[I_ADAW] + (size_t)l * 1024 * NMOD + col0 + 4 * lane;
#pragma unroll 4
        for (int kk = 0; kk < 128; ++kk) { const int k = wave * 128 + kk; const f32x4 w = *(const f32x4*)(W + (size_t)k * NMOD);
#pragma unroll
            for (int b = 0; b < 5; ++b) acc[b] += w * sil[b * 1024 + k]; }
#pragma unroll
        for (int b = 0; b < 5; ++b) *(LAS f32x4*)(red + (wave * 5 + b) * 256 + 4 * lane) = acc[b];
        __syncthreads();
        for (int i = tid; i < 5 * 256; i += 512) { const int b = i >> 8, c = i & 255; float s = a.in[I_ADAB][l * NMOD + col0 + c];
#pragma unroll
            for (int w = 0; w < 8; ++w) s += red[(w * 5 + b) * 256 + c];
            ((float*)(ws + WS_MOD))[((size_t)l * 5 + b) * NMOD + col0 + c] = s; }
        __syncthreads();
    }
    const int gt = bx * 512 + tid, NT = G * 512;
    if (bx == G - 1) { for (int i = tid; i < 1024; i += 512) { const int pos = i >> 4, f = i & 15; const float inv = powf(10000.f, -(float)(2 * f) / 32.f), ang = (float)pos * inv;
        ((float*)(ws + WS_ROPE))[i] = cosf(ang); ((float*)(ws + WS_ROPE))[1024 + i] = sinf(ang); } }
    for (int i = gt; i < 2 * 2 * MALL; i += NT) ((float*)(ws + WS_STAT))[i] = 0.f;
    for (int i = gt; i < 2 * 64 * 1024 / 8; i += NT) { const int j = i / (64 * 1024 / 8), r = i % (64 * 1024 / 8);
        *(u32x4*)(ws + WS_MLA + j * W_MLA_STRIDE + OFF_WQKVA + (size_t)704 * 1024 * 2 + (size_t)r * 16) = (u32x4){0u, 0u, 0u, 0u}; }
    for (int i = gt; i < 2 * 8 * 256 * 256 / 2; i += NT) {
        const int e = i * 2, j = e / (8 * 65536), g = (e / 65536) % 8, rr = (e / 256) % 256, cc = e % 256;
        unsigned w = 0u;
        if ((rr >> 7) == (cc >> 7)) { const float* s = a.in[I_GWS] + (((size_t)j * 8 + g) * 128 + (rr & 127)) * 128 + (cc & 127); w = pk2(s[0], s[1]); }
        *(unsigned*)(ws + WS_GM + j * W_GM_STRIDE + OFF_WBLK + (size_t)(e % (8 * 65536)) * 2) = w; }
    LAS float* scr = (LAS float*)(lds + wave * 8704);
    unsigned* ctr = (unsigned*)(ws + WS_CTL);
    constexpr int I_FF = 2048, I_QA = 192, I_KVA = 160, I_QB = 288, I_KVB = 256, I_OO = 512, I_MLA = I_QA + I_KVA + I_QB + I_KVB + I_OO, I_IN = 2048, I_OUT = 1024, I_GMI = I_IN + I_OUT;
    constexpr int NITEMS = 4 * 2 * I_FF + 2 * I_MLA + 2 * I_GMI;
    for (;;) {
        int it = 0; if (lane == 0) it = (int)atomicAdd(ctr, 1u); it = __builtin_amdgcn_readfirstlane(it);
        if (it >= NITEMS) break;
        if (it < 4 * 2 * I_FF) { const int l = it / (2 * I_FF), r = it % (2 * I_FF);
            if (r < I_FF) p0_transpose_item(a.in[I_W1] + (size_t)l * DM * FFH, DM, FFH, (bf16_t*)(ws + WS_W1 + l * W_FFN_STRIDE), 0, scr, r, lane);
            else p0_transpose_item(a.in[I_W2] + (size_t)l * DM * FFH, FFH, DM, (bf16_t*)(ws + WS_W2 + l * W_FFN_STRIDE), 0, scr, r - I_FF, lane);
            continue; }
        it -= 4 * 2 * I_FF;
        if (it < 2 * I_MLA) { const int j = it / I_MLA; int r = it % I_MLA; unsigned char* wb = ws + WS_MLA + j * W_MLA_STRIDE;
            if (r < I_QA) { p0_transpose_item(a.in[I_WQA] + (size_t)j * DM * QLORA, DM, QLORA, (bf16_t*)(wb + OFF_WQKVA), 0, scr, r, lane); continue; } r -= I_QA;
            if (r < I_KVA) { p0_transpose_item(a.in[I_WKVA] + (size_t)j * DM * 320, DM, 320, (bf16_t*)(wb + OFF_WQKVA), 384, scr, r, lane); continue; } r -= I_KVA;
            if (r < I_QB) { p0_transpose_item(a.in[I_WQB] + (size_t)j * QLORA * 1536, QLORA, 1536, (bf16_t*)(wb + OFF_WQB), 0, scr, r, lane); continue; } r -= I_QB;
            if (r < I_KVB) { p0_transpose_item(a.in[I_WKVB] + (size_t)j * KVLORA * 2048, KVLORA, 2048, (bf16_t*)(wb + OFF_WKVB), 0, scr, r, lane); continue; } r -= I_KVB;
            p0_transpose_item(a.in[I_WO] + (size_t)j * DM * DM, DM, DM, (bf16_t*)(wb + OFF_WO), 0, scr, r, lane); continue; }
        it -= 2 * I_MLA;
        { const int j = it / I_GMI, r = it % I_GMI; unsigned char* wb = ws + WS_GM + j * W_GM_STRIDE;
            if (r < I_IN) p0_transpose_item(a.in[I_GWIN] + (size_t)j * DM * 4096, DM, 4096, (bf16_t*)(wb + OFF_WIN), 0, scr, r, lane);
            else p0_transpose_item(a.in[I_GWOUT] + (size_t)j * GMH * DM, GMH, DM, (bf16_t*)(wb + OFF_WOUT), 0, scr, r - I_IN, lane); }
    }
}

__device__ __forceinline__ void modulate_phase(const float* xlat, const float* xctx, const float* gain, const float* modl, int sh_off, int sc_off, bf16_t* H, int nrows, int gw, int NGW, int lane) {
    for (int r = gw; r < nrows; r += NGW) {
        const bool lat = r < MLAT; const float* xr = lat ? xlat + (size_t)r * DM : xctx + (size_t)(r - MLAT) * DM; const int b = lat ? (r >> 12) : 4;
        const float* mp = modl + (size_t)b * NMOD;
        f32x4 v[4]; float s = 0.f;
#pragma unroll
        for (int j = 0; j < 4; ++j) { v[j] = *(const f32x4*)(xr + 4 * lane + 256 * j); s += (v[j].x * v[j].x + v[j].y * v[j].y) + (v[j].z * v[j].z + v[j].w * v[j].w); }
        const float rinv = 1.0f / sqrtf(wave_sum(s) * (1.f / DM) + EPS);
#pragma unroll
        for (int j = 0; j < 4; ++j) { const int c = 4 * lane + 256 * j; const f32x4 g = *(const f32x4*)(gain + c), sc = *(const f32x4*)(mp + sc_off + c), sh = *(const f32x4*)(mp + sh_off + c);
            const f32x4 y = (v[j] * rinv) * g * (sc + 1.0f) + sh;
            u32x2 w; w.x = cvt_pk_bf16(y[0], y[1]); w.y = cvt_pk_bf16(y[2], y[3]); *(u32x2*)(H + (size_t)r * DM + c) = w; }
    }
}
__device__ __forceinline__ void lora_norm_phase(const float* qkva, const float* qan, const float* kvan, bf16_t* CQ, bf16_t* CKV, int nrows, int gw, int NGW, int lane) {
    for (int r = gw; r < nrows; r += NGW) {
        const float* p = qkva + (size_t)r * NQKVA;
        f32x2 q[3]; float s = 0.f;
#pragma unroll
        for (int j = 0; j < 3; ++j) { q[j] = *(const f32x2*)(p + 2 * lane + 128 * j); s += q[j].x * q[j].x + q[j].y * q[j].y; }
        const f32x4 kv = *(const f32x4*)(p + 384 + 4 * lane); const float s2 = (kv.x * kv.x + kv.y * kv.y) + (kv.z * kv.z + kv.w * kv.w);
        const float rq = 1.0f / sqrtf(wave_sum(s) * (1.f / QLORA) + EPS), rk = 1.0f / sqrtf(wave_sum(s2) * (1.f / KVLORA) + EPS);
#pragma unroll
        for (int j = 0; j < 3; ++j) { const int c = 2 * lane + 128 * j; const f32x2 g = *(const f32x2*)(qan + c); *(unsigned*)(CQ + (size_t)r * QLORA + c) = cvt_pk_bf16(q[j].x * rq * g.x, q[j].y * rq * g.y); }
        { const int c = 4 * lane; const f32x4 g = *(const f32x4*)(kvan + c); u32x2 w; w.x = cvt_pk_bf16(kv.x * rk * g.x, kv.y * rk * g.y); w.y = cvt_pk_bf16(kv.z * rk * g.z, kv.w * rk * g.w);
          *(u32x2*)(CKV + (size_t)r * KVLORA + c) = w; }
    }
}
__device__ __forceinline__ void unpack8(const u32x4 w, float* f) { f[0] = bf_lo(w.x); f[1] = bf_hi(w.x); f[2] = bf_lo(w.y); f[3] = bf_hi(w.y); f[4] = bf_lo(w.z); f[5] = bf_hi(w.z); f[6] = bf_lo(w.w); f[7] = bf_hi(w.w); }
__device__ __forceinline__ u32x4 pack8(const float* f) { u32x4 w; w.x = cvt_pk_bf16(f[0], f[1]); w.y = cvt_pk_bf16(f[2], f[3]); w.z = cvt_pk_bf16(f[4], f[5]); w.w = cvt_pk_bf16(f[6], f[7]); return w; }
__device__ __forceinline__ void qk_norm_rope_phase(bf16_t* Qraw, bf16_t* KVraw, bf16_t* KPE, const float* qkva, const float* qn, const float* kn, const float* rope, int nrows_q, int nrows, int gw, int NGW, int lane) {
    const int h = lane >> 3, sub = lane & 7, fbase = (sub & 1) * 8;
    float gqn[16], gqp[8], gkn[16], gkp[8];
#pragma unroll
    for (int i = 0; i < 16; ++i) { gqn[i] = qn[16 * sub + i]; gkn[i] = kn[16 * sub + i]; }
#pragma unroll
    for (int i = 0; i < 8; ++i) { gqp[i] = qn[128 + 8 * sub + i]; gkp[i] = kn[128 + 8 * sub + i]; }
    for (int r = gw; r < nrows; r += NGW) {
        const bool lat = r < MLAT; const int s = r & (SEQ - 1), pos = (sub < 4) ? (s >> 6) : (s & 63);
        float cs[8], sn[8];
#pragma unroll
        for (int i = 0; i < 8; ++i) { cs[i] = lat ? rope[pos * 16 + fbase + i] : 1.f; sn[i] = lat ? rope[1024 + pos * 16 + fbase + i] : 0.f; }
        if (r < nrows_q) {
            bf16_t* p = Qraw + (size_t)r * (NH * QKD) + h * QKD;
            float x[16], y[8]; unpack8(*(const u32x4*)(p + 16 * sub), x); unpack8(*(const u32x4*)(p + 16 * sub + 8), x + 8); unpack8(*(const u32x4*)(p + 128 + 8 * sub), y);
            float ss = 0.f;
#pragma unroll
            for (int i = 0; i < 16; ++i) ss += x[i] * x[i];
#pragma unroll
            for (int i = 0; i < 8; ++i) ss += y[i] * y[i];
            ss += __shfl_xor(ss, 1); ss += __shfl_xor(ss, 2); ss += __shfl_xor(ss, 4);
            const float rinv = 1.0f / sqrtf(ss * (1.f / QKD) + EPS);
#pragma unroll
            for (int i = 0; i < 16; ++i) x[i] = x[i] * rinv * gqn[i];
            float z[8];
#pragma unroll
            for (int i = 0; i < 8; ++i) { y[i] = y[i] * rinv * gqp[i]; const float o = __shfl_xor(y[i], 2); z[i] = y[i] * cs[i] + ((sub & 2) ? o : -o) * sn[i]; }
            *(u32x4*)(p + 16 * sub) = pack8(x); *(u32x4*)(p + 16 * sub + 8) = pack8(x + 8); *(u32x4*)(p + 128 + 8 * sub) = pack8(z);
        }
        {
            bf16_t* p = KVraw + (size_t)r * (NH * 256) + h * 256;
            float x[16], y[8]; unpack8(*(const u32x4*)(p + 16 * sub), x); unpack8(*(const u32x4*)(p + 16 * sub + 8), x + 8);
            const float* kp = qkva + (size_t)r * NQKVA + 640 + 8 * sub; const f32x4 k0 = *(const f32x4*)kp, k1 = *(const f32x4*)(kp + 4);
            y[0] = k0.x; y[1] = k0.y; y[2] = k0.z; y[3] = k0.w; y[4] = k1.x; y[5] = k1.y; y[6] = k1.z; y[7] = k1.w;
            float ss = 0.f;
#pragma unroll
            for (int i = 0; i < 16; ++i) ss += x[i] * x[i];
#pragma unroll
            for (int i = 0; i < 8; ++i) ss += y[i] * y[i];
            ss += __shfl_xor(ss, 1); ss += __shfl_xor(ss, 2); ss += __shfl_xor(ss, 4);
            const float rinv = 1.0f / sqrtf(ss * (1.f / QKD) + EPS);
#pragma unroll
            for (int i = 0; i < 16; ++i) x[i] = x[i] * rinv * gkn[i];
            float z[8];
#pragma unroll
            for (int i = 0; i < 8; ++i) { y[i] = y[i] * rinv * gkp[i]; const float o = __shfl_xor(y[i], 2); z[i] = y[i] * cs[i] + ((sub & 2) ? o : -o) * sn[i]; }
            *(u32x4*)(p + 16 * sub) = pack8(x); *(u32x4*)(p + 16 * sub + 8) = pack8(x + 8);
            *(u32x4*)(KPE + (size_t)r * (NH * QKR) + h * QKR + 8 * sub) = pack8(z);
        }
    }
}
__device__ __forceinline__ void gm_ln_phase(bf16_t* Vt, const float* S1, const float* S2, const float* lng, const float* lnb, int ntok, int gt, int NT) {
    const int per_row = ntok / 8;
    for (int i = gt; i < GMH * per_row; i += NT) {
        const int c = i / per_row, t0 = (i % per_row) * 8; bf16_t* p = Vt + (size_t)c * MALL + t0;
        float x[8]; unpack8(*(const u32x4*)p, x); const float g = lng[c], b = lnb[c];
#pragma unroll
        for (int e = 0; e < 8; e += 4) { const f32x4 a1 = *(const f32x4*)(S1 + t0 + e), a2 = *(const f32x4*)(S2 + t0 + e);
#pragma unroll
            for (int k = 0; k < 4; ++k) { const float mu = a1[k] * (1.f / GMH), var = fmaxf(a2[k] * (1.f / GMH) - mu * mu, 0.f), rstd = 1.0f / sqrtf(var + EPS); x[e + k] = (x[e + k] - mu) * rstd * g + b; } }
        *(u32x4*)p = pack8(x);
    }
}

__global__ void __launch_bounds__(512, 2) fwd_mega(Args a) {
    extern __shared__ __attribute__((aligned(16))) unsigned char lds_raw[];
    LAS unsigned char* lds = (LAS unsigned char*)lds_raw;
    cg::grid_group grid = cg::this_grid();
    const int G = gridDim.x, bx = blockIdx.x;
    const int vcu = (G % 8 == 0) ? (bx % 8) * (G / 8) + bx / 8 : bx;
    const int NGW = G * 8, NTH = G * 512;
    unsigned char* ws = a.ws;
    const int lo = a.ph_lo, hi = a.ph_hi;
    int ph = 0;
#define PHASE_BEGIN if (lo <= ph && ph < hi) { int tid = threadIdx.x; asm volatile("" : "+v"(tid));   \
    const int lane = tid & 63, wave = __builtin_amdgcn_readfirstlane(tid >> 6), gw = vcu * 8 + wave, gt = bx * 512 + tid; (void)lane; (void)wave; (void)gw; (void)gt;
#define PHASE_END   if (ph + 1 < hi) grid.sync(); } ++ph;

    float* const modb = (float*)(ws + WS_MOD);
    const float* const rope = (const float*)(ws + WS_ROPE);
    bf16_t* const Hb = (bf16_t*)(ws + WS_H);
    float* const Xc = (float*)(ws + WS_XC);

    PHASE_BEGIN
#ifndef NO_P0
 p0_phase(a, ws, lds, bx, G, tid, wave, lane);
#endif
 PHASE_END

    for (int l = 0; l < DEPTH; ++l) {
        const int j = l >> 1;
        const bool mla = (l & 1) == 0;
        const int Mrows = (l == 0 || l == 1) ? MALL : (l == 2 ? MALL : MLAT);
        const int Mres = (l <= 1) ? MALL : MLAT;
        const float* xlat = (l == 0) ? a.in[I_X] : a.out; const float* xctx = (l == 0) ? a.in[I_CTX] : Xc;
        const float* modl = modb + (size_t)l * 5 * NMOD;
        if (mla) {
            unsigned char* wb = ws + WS_MLA + j * W_MLA_STRIDE;
            float* QKVA = (float*)(ws + WS_QKVA); bf16_t* CQ = (bf16_t*)(ws + WS_CQ); bf16_t* CKV = (bf16_t*)(ws + WS_CKV);
            bf16_t* Qraw = (bf16_t*)(ws + WS_BIG + OFF_QRAW); bf16_t* KVraw = (bf16_t*)(ws + WS_BIG + OFF_KVRAW); bf16_t* KPE = (bf16_t*)(ws + WS_BIG + OFF_KPE);
            const int Mq = (l == 0) ? MALL : MLAT;
            PHASE_BEGIN modulate_phase(xlat, xctx, a.in[I_NMG] + l * DM, modl, 0, DM, Hb, Mrows, gw, NGW, lane); PHASE_END
            PHASE_BEGIN { pg8::Gemm g = pg8::plain_gemm(Hb, DM, (const bf16_t*)(wb + OFF_WQKVA), DM, DM); pg8::StaticOrder S; S.init(Mrows, NQKVA, G, bx);
                pg8::EpiF32 E{QKVA, NQKVA}; pg8::gemm_phase<pg8::EpiF32, pg8::StaticOrder, true, true>(lds, g, S, E); } PHASE_END
            PHASE_BEGIN lora_norm_phase(QKVA, a.in[I_QAN] + j * QLORA, a.in[I_KVAN] + j * KVLORA, CQ, CKV, Mrows, gw, NGW, lane); PHASE_END
            PHASE_BEGIN { { pg8::Gemm g = pg8::plain_gemm(CQ, QLORA, (const bf16_t*)(wb + OFF_WQB), QLORA, QLORA); pg8::StaticOrder S; S.init(Mq, NH * QKD, G, bx);
                  pg8::EpiBf16<0> E{Qraw, NH * QKD}; pg8::gemm_phase<pg8::EpiBf16<0>, pg8::StaticOrder, true, true>(lds, g, S, E); }
                { pg8::Gemm g = pg8::plain_gemm(CKV, KVLORA, (const bf16_t*)(wb + OFF_WKVB), KVLORA, KVLORA); pg8::StaticOrder S; S.init(Mrows, NH * 256, G, G - 1 - bx);
                  pg8::EpiBf16<0> E{KVraw, NH * 256}; pg8::gemm_phase<pg8::EpiBf16<0>, pg8::StaticOrder, true, true>(lds, g, S, E); } } PHASE_END
            PHASE_BEGIN
#ifndef NO_QKN
 qk_norm_rope_phase(Qraw, KVraw, KPE, QKVA, a.in[I_QN] + j * QKD, a.in[I_KN] + j * QKD, rope, Mq, Mrows, gw, NGW, lane);
#endif
 PHASE_END
            PHASE_BEGIN {
#ifndef NO_ATT
                for (int u = vcu; u < NB * NH * (SEQ / 256); u += G) { const int bh = u >> 4, qb = u & 15, b = bh >> 3, h = bh & 7;
                    att::attn_unit(Qraw, KVraw, KPE, Hb, h, b * SEQ + qb * 256, MLAT + b * CTX, b * SEQ, (CTX + SEQ) / 64, (char*)lds_raw); }
                if (l == 0) for (int u = vcu; u < NB * NH; u += G) { const int b = u >> 3, h = u & 7;
                    att::attn_unit(Qraw, KVraw, KPE, Hb, h, MLAT + b * CTX, MLAT + b * CTX, 0, CTX / 64, (char*)lds_raw); }
#endif
            } PHASE_END
            PHASE_BEGIN { pg8::Gemm g = pg8::plain_gemm(Hb, DM, (const bf16_t*)(wb + OFF_WO), DM, DM); pg8::StaticOrder S; S.init(Mres, DM, G, bx);
                pg8::EpiResid E{xlat, xctx, a.out, Xc, modl + 2 * DM}; pg8::gemm_phase<pg8::EpiResid, pg8::StaticOrder, true, true>(lds, g, S, E); } PHASE_END
        } else {
            unsigned char* wb = ws + WS_GM + j * W_GM_STRIDE;
            bf16_t* GU = (bf16_t*)(ws + WS_BIG + OFF_GU); bf16_t* GVT = (bf16_t*)(ws + WS_BIG + OFF_GVT);
            float* S1 = (float*)(ws + WS_STAT) + (size_t)j * 2 * MALL; float* S2 = S1 + MALL;
            PHASE_BEGIN modulate_phase(xlat, xctx, a.in[I_NMG] + l * DM, modl, 0, DM, Hb, Mres, gw, NGW, lane); PHASE_END
            PHASE_BEGIN { { pg8::Gemm g = pg8::plain_gemm(Hb, DM, (const bf16_t*)(wb + OFF_WIN), DM, DM); pg8::StaticOrder S; S.init(Mres, GMH, G, bx);
                  pg8::EpiBf16<1> E{GU, GMH}; pg8::gemm_phase<pg8::EpiBf16<1>, pg8::StaticOrder, true, true>(lds, g, S, E); }
                { pg8::Gemm g = pg8::plain_gemm((const bf16_t*)(wb + OFF_WIN) + (size_t)GMH * DM, DM, Hb, DM, DM); pg8::StaticOrder S; S.init(GMH, Mres, G, G - 1 - bx);
                  pg8::EpiGeluT E{GVT, MALL, S1, S2}; pg8::gemm_phase<pg8::EpiGeluT, pg8::StaticOrder, true, true>(lds, g, S, E); } } PHASE_END
            PHASE_BEGIN gm_ln_phase(GVT, S1, S2, a.in[I_GLNG] + j * GMH, a.in[I_GLNB] + j * GMH, Mres, gt, NTH); PHASE_END
            PHASE_BEGIN { pg8::Gemm g; g.A = (const char*)(wb + OFF_WBLK); g.B = (const char*)GVT; g.lda = 256; g.ldb = MALL; g.K = 256;
                g.sAm = 0; g.sAn = (size_t)256 * 256 * 2; g.sBm = (size_t)256 * 2; g.sBn = (size_t)256 * MALL * 2;
                pg8::StaticOrder S; S.init(Mres, GMH, G, bx);
                pg8::EpiGate E{GU, GMH, a.in[I_GBS] + j * 8 * 128}; pg8::gemm_phase<pg8::EpiGate, pg8::StaticOrder, true, true>(lds, g, S, E); } PHASE_END
            PHASE_BEGIN { pg8::Gemm g = pg8::plain_gemm(GU, GMH, (const bf16_t*)(wb + OFF_WOUT), GMH, GMH); pg8::StaticOrder S; S.init(Mres, DM, G, bx);
                pg8::EpiResid E{xlat, xctx, a.out, Xc, modl + 2 * DM}; pg8::gemm_phase<pg8::EpiResid, pg8::StaticOrder, true, true>(lds, g, S, E); } PHASE_END
        }
        {
            bf16_t* FH = (bf16_t*)(ws + WS_BIG + OFF_FFH);
            PHASE_BEGIN modulate_phase(a.out, Xc, a.in[I_NFG] + l * DM, modl, 3 * DM, 4 * DM, Hb, Mres, gw, NGW, lane); PHASE_END
            PHASE_BEGIN { pg8::Gemm g = pg8::plain_gemm(Hb, DM, (const bf16_t*)(ws + WS_W1 + l * W_FFN_STRIDE), DM, DM); pg8::StaticOrder S; S.init(Mres, FFH, G, bx);
                pg8::EpiBf16<2> E{FH, FFH}; pg8::gemm_phase<pg8::EpiBf16<2>, pg8::StaticOrder, true, true>(lds, g, S, E); } PHASE_END
            PHASE_BEGIN { pg8::Gemm g = pg8::plain_gemm(FH, FFH, (const bf16_t*)(ws + WS_W2 + l * W_FFN_STRIDE), FFH, FFH); pg8::StaticOrder S; S.init(Mres, DM, G, bx);
                pg8::EpiResid E{a.out, Xc, a.out, Xc, modl + 5 * DM}; pg8::gemm_phase<pg8::EpiResid, pg8::StaticOrder, true, true>(lds, g, S, E); } PHASE_END
        }
    }
#undef PHASE_BEGIN
#undef PHASE_END
}
constexpr int NPHASES = 1 + 10 + 8 + 10 + 8;

extern "C" void kernel_launch(void* const* d_in, const int* in_sizes, int n_in, void* d_out, int out_size, void* d_ws, size_t ws_size, hipStream_t stream) {
    static int grid = 0;
    if (grid == 0) {
        if (n_in != 25 || out_size != MLAT * DM || ws_size < WS_END) { fprintf(stderr, "kernel_launch: unexpected shapes: n_in %d out %d ws %zu (need %zu)\n", n_in, out_size, ws_size, (size_t)WS_END); grid = -1; return; }
        int dev = 0, cus = 0, per_cu = 0;
        hipGetDevice(&dev); hipDeviceGetAttribute(&cus, hipDeviceAttributeMultiprocessorCount, dev);
        if (hipFuncSetAttribute((const void*)fwd_mega, hipFuncAttributeMaxDynamicSharedMemorySize, LDS_BYTES) != hipSuccess) { fprintf(stderr, "kernel_launch: hipFuncSetAttribute failed\n"); grid = -1; return; }
        hipOccupancyMaxActiveBlocksPerMultiprocessor(&per_cu, (const void*)fwd_mega, 512, LDS_BYTES);
        (void)hipGetLastError();
        if (per_cu < 1) per_cu = 1;
        grid = cus * per_cu;
        fprintf(stderr, "kernel_launch: cus %d per_cu %d grid %d\n", cus, per_cu, grid);
    }
    if (grid < 0) return;
    hipMemsetAsync((char*)d_ws + WS_CTL, 0, 4096, stream);
    Args a{};
    for (int i = 0; i < 25; ++i) a.in[i] = (const float*)d_in[i];
    a.out = (float*)d_out; a.ws = (unsigned char*)d_ws;
#if ONE_LAUNCH
    a.ph_lo = 0; a.ph_hi = NPHASES;
    void* args[] = {&a};
    hipError_t e = hipLaunchCooperativeKernel((const void*)fwd_mega, dim3(grid), dim3(512), args, LDS_BYTES, stream);
    if (e != hipSuccess) fprintf(stderr, "kernel_launch: cooperative launch failed: %s (grid %d)\n", hipGetErrorString(e), grid);
#else
    for (int p = 0; p < NPHASES; ++p) { a.ph_lo = p; a.ph_hi = p + 1; hipLaunchKernelGGL(fwd_mega, dim3(grid), dim3(512), LDS_BYTES, stream, a); }
    hipError_t e = hipPeekAtLastError();
    if (e != hipSuccess) fprintf(stderr, "kernel_launch: launch failed: %s\n", hipGetErrorString(e));
#endif
}
```

```cpp
#include <hip/hip_runtime.h>
#include <hip/hip_cooperative_groups.h>
#include <hip/hip_bf16.h>
#include <cstdio>
#include <cstdint>
namespace cg = cooperative_groups;

#ifndef ONE_LAUNCH
#define ONE_LAUNCH 1
#endif
#ifndef REP_ATT
#define REP_ATT 1
#endif
#ifndef REP_F2
#define REP_F2 1
#endif
#ifndef REP_P0
#define REP_P0 1
#endif
#ifndef REP_G2
#define REP_G2 1
#endif
#ifndef REP_M3
#define REP_M3 1
#endif
#ifndef REP_MOD
#define REP_MOD 1
#endif
#ifndef REP_BAR
#define REP_BAR 1
#endif
#ifndef REP_M24
#define REP_M24 1
#endif
#ifndef REP_F3X
#define REP_F3X 0
#endif

constexpr int DM = 1024, NB = 4, SEQ = 4096, CTX = 256, DEPTH = 4;
constexpr int MLAT = NB * SEQ, MCTX = NB * CTX, MALL = MLAT + MCTX;
constexpr int NH = 8, QKN = 128, QKR = 64, VD = 128, QKD = 192, QLORA = 384, KVLORA = 256;
constexpr int NQKVA = 768;
constexpr int GMH = 2048, FFH = 4096, NMOD = 6 * DM;
constexpr float EPS = 1e-6f;

#define LAS __attribute__((address_space(3)))
typedef unsigned short bf16_t;
typedef short bf16x8 __attribute__((ext_vector_type(8)));
typedef float f32x4 __attribute__((ext_vector_type(4)));
typedef float f32x2 __attribute__((ext_vector_type(2)));
typedef unsigned u32x4 __attribute__((ext_vector_type(4)));
typedef unsigned u32x2 __attribute__((ext_vector_type(2)));

__device__ __forceinline__ unsigned cvt_pk_bf16(float lo, float hi) { unsigned r; asm volatile("v_cvt_pk_bf16_f32 %0, %1, %2" : "=v"(r) : "v"(lo), "v"(hi)); return r; }
__device__ __forceinline__ float bf_lo(unsigned w) { return __uint_as_float(w << 16); }
__device__ __forceinline__ float bf_hi(unsigned w) { return __uint_as_float(w & 0xffff0000u); }
__device__ __forceinline__ float shx(float v, int o, int lane) { return __int_as_float(__builtin_amdgcn_ds_bpermute((lane ^ o) << 2, __float_as_int(v))); }
template <int N> __device__ __forceinline__ float dpp_ror(float v) { return __int_as_float(__builtin_amdgcn_update_dpp(0, __float_as_int(v), 0x120 + N, 0xf, 0xf, true)); }
__device__ __forceinline__ float row16_sum(float v) { v += dpp_ror<8>(v); v += dpp_ror<4>(v); v += dpp_ror<2>(v); v += dpp_ror<1>(v); return v; }
__device__ __forceinline__ float wave_sum(float v, int lane) {
#pragma unroll
    for (int o = 1; o < 64; o <<= 1) v += shx(v, o, lane);
    return v;
}

namespace pg8 {
#define PG8_LAS __attribute__((address_space(3)))
constexpr int BM = 256, BK = 64, HALF = 128, HTB = HALF * BK * 2  , STAGE_BYTES = 8 * HTB, NXCD = 8, WGM = 8;

__host__ __device__ __forceinline__ int lds_byte(int r, int c) { const int st = (r >> 4) * 2 + (c >> 5), rr = r & 15, cc = c & 31, ob = rr * 64 + cc * 2; return st * 1024 + (ob ^ (((ob >> 9) & 1) << 5)); }
__host__ __device__ __forceinline__ void stage_rc(int b, int& R, int& C) { const int st = b / 1024, sb = b % 1024, swz = sb ^ (((sb >> 9) & 1) << 5); R = (st >> 1) * 16 + swz / 64; C = (st & 1) * 32 + (swz % 64) / 2; }
__host__ __device__ __forceinline__ int perm32(int rho) { const int n = rho >> 4, i = rho & 15; return 8 * (i >> 2) + 4 * n + (i & 3); }

struct Unit { int pm, pn, pk; };
struct Gemm {
    const char* A; const char* B; int lda, ldb, K; size_t sAm, sAn, sBm, sBn, sAk, sBk;
    __device__ __forceinline__ const char* a_of(const Unit& u) const { return A + (size_t)u.pm * sAm + (size_t)u.pn * sAn + (size_t)u.pk * sAk; }
    __device__ __forceinline__ const char* b_of(const Unit& u) const { return B + (size_t)u.pm * sBm + (size_t)u.pn * sBn + (size_t)u.pk * sBk; }
};
__device__ __forceinline__ Gemm plain_gemm(const bf16_t* A, int lda, const bf16_t* Bt, int ldb, int K) {
    Gemm g; g.A = (const char*)A; g.B = (const char*)Bt; g.lda = lda; g.ldb = ldb; g.K = K;
    g.sAm = (size_t)BM * lda * 2; g.sAn = 0; g.sBm = 0; g.sBn = (size_t)BM * ldb * 2; g.sAk = 0; g.sBk = 0; return g;
}

struct StaticOrder {
    int nM, nN, nwg, G, c;
    __host__ __device__ __forceinline__ void init(int M, int N, int G_, int c_) { nM = M / BM; nN = N / BM; nwg = nM * nN; G = G_; c = c_; }
    __host__ __device__ __forceinline__ bool next(int i, Unit& u) const {
        const long L = (long)i * G + c; if (L >= nwg) return false;
        int wgid = (int)L; { const int q = nwg / NXCD, r = nwg % NXCD, xcd = wgid % NXCD, off = wgid / NXCD; wgid = (xcd < r ? xcd * (q + 1) : r * (q + 1) + (xcd - r) * q) + off; }
        const int nig = WGM * nN, gid = wgid / nig, fm = gid * WGM, gsz = (nM - fm) < WGM ? (nM - fm) : WGM;
        u.pm = fm + ((wgid % nig) % gsz); u.pn = (wgid % nig) / gsz; u.pk = 0; return true;
    }
    __device__ __forceinline__ void a_ready(const Unit&) const {}
    __device__ __forceinline__ void done(const Unit&) const {}
};

struct SplitOrder {
    int nsub, G, c;
    __device__ __forceinline__ void init(int nsplit, int G_, int c_) { nsub = 16 * nsplit; G = G_; c = c_; }
    __device__ __forceinline__ bool next(int i, Unit& u) const { const int L = i * G + c; if (L >= nsub) return false; u.pk = L >> 4; u.pm = MLAT / BM + (L & 3); u.pn = (L >> 2) & 3; return true; }
    __device__ __forceinline__ void a_ready(const Unit&) const {}
    __device__ __forceinline__ void done(const Unit&) const {}
};

__device__ __forceinline__ f32x2 gelu_pk(f32x2 v) {
    const f32x2 av = __builtin_elementwise_abs(v), d = av * 0.2316418882f + 1.0f;
    f32x2 t; t.x = __builtin_amdgcn_rcpf(d.x); t.y = __builtin_amdgcn_rcpf(d.y);
    f32x2 q = t * 0.5307027145f + (-0.7265760135f); q = q * t + 0.7107068705f; q = q * t + (-0.142248368f); q = q * t + 0.127414796f; q = q * t;
    const f32x2 s = (v * v) * (-0.72134752044f);
    f32x2 e; e.x = __builtin_amdgcn_exp2f(s.x); e.y = __builtin_amdgcn_exp2f(s.y);
    const f32x2 m = v * (q * e), r = v - m;
    f32x2 o; o.x = v.x < 0.f ? m.x : r.x; o.y = v.y < 0.f ? m.y : r.y; return o;
}
__device__ __forceinline__ f32x4 act4(f32x4 v, int act) {
    if (act == 1) { f32x2 a = gelu_pk((f32x2){v[0], v[1]}), b = gelu_pk((f32x2){v[2], v[3]}); return (f32x4){a.x, a.y, b.x, b.y}; }
    if (act == 2) { f32x4 r; for (int i = 0; i < 4; ++i) { const float t = fmaxf(v[i], 0.f); r[i] = t * t; } return r; }
    return v;
}


template <int ACT> struct EpiBf16 {
    static constexpr bool PERM = true, AFTER_DRAIN = false, PERM64 = true;
    bf16_t* O; int ldc; const float* ssq; const float* bias; int ldbias; float inv_n; bool all_rows;
    __device__ __forceinline__ void operator()(const f32x4 (&acc)[2][2][4][2], const Unit& u, int wr, int wc, int fr, int fq) const {
        const int row0 = u.pm * BM + wr * 64 + fr, col0 = u.pn * BM + wc * 64 + 8 * fq;
        const bool fused = ssq != nullptr && (all_rows || u.pm < MLAT / BM);
        f32x4 bv[2][2];
#pragma unroll
        for (int bj = 0; bj < 2; ++bj)
#pragma unroll
            for (int n = 0; n < 2; ++n) bv[bj][n] = (fused && bias != nullptr) ? *(const f32x4*)(bias + (size_t)(u.pm >> 4) * ldbias + col0 + bj * 32 + 4 * n) : (f32x4){0.f, 0.f, 0.f, 0.f};
#pragma unroll
        for (int ai = 0; ai < 2; ++ai)
#pragma unroll
            for (int m = 0; m < 4; ++m) { bf16_t* rowp = O + (size_t)(row0 + ai * HALF + m * 16) * ldc + col0;
                const float rr = fused ? 1.0f / sqrtf(ssq[row0 + ai * HALF + m * 16] * inv_n + EPS) : 1.f;
#pragma unroll
                for (int bj = 0; bj < 2; ++bj) { const f32x4 v0 = act4(acc[ai][bj][m][0] * rr + bv[bj][0], ACT), v1 = act4(acc[ai][bj][m][1] * rr + bv[bj][1], ACT);
                    u32x4 w; w.x = cvt_pk_bf16(v0[0], v0[1]); w.y = cvt_pk_bf16(v0[2], v0[3]); w.z = cvt_pk_bf16(v1[0], v1[1]); w.w = cvt_pk_bf16(v1[2], v1[3]);
                    *(u32x4*)(rowp + bj * 32) = w; } }
    }
};
struct EpiF32 {
    static constexpr bool PERM = false, AFTER_DRAIN = false, PERM64 = false;
    float* O; int ldc; const float* ssq; const float* bias; int ldbias;
    __device__ __forceinline__ void operator()(const f32x4 (&acc)[2][2][4][2], const Unit& u, int wr, int wc, int fr, int fq) const {
        const int row0 = u.pm * BM + wr * 64 + fr, col0 = u.pn * BM + wc * 32 + 4 * fq;
        const bool fused = ssq != nullptr && u.pm < MLAT / BM;
        f32x4 bv[2][2];
#pragma unroll
        for (int bj = 0; bj < 2; ++bj)
#pragma unroll
            for (int n = 0; n < 2; ++n) bv[bj][n] = fused ? *(const f32x4*)(bias + (size_t)(u.pm >> 4) * ldbias + col0 + bj * HALF + n * 16) : (f32x4){0.f, 0.f, 0.f, 0.f};
#pragma unroll
        for (int ai = 0; ai < 2; ++ai)
#pragma unroll
            for (int m = 0; m < 4; ++m) { float* rowp = O + (size_t)(row0 + ai * HALF + m * 16) * ldc + col0;
                const float rr = fused ? 1.0f / sqrtf(ssq[row0 + ai * HALF + m * 16] * (1.f / DM) + EPS) : 1.f;
#pragma unroll
                for (int bj = 0; bj < 2; ++bj)
#pragma unroll
                    for (int n = 0; n < 2; ++n) *(f32x4*)(rowp + bj * HALF + n * 16) = acc[ai][bj][m][n] * rr + bv[bj][n]; }
    }
};
struct EpiQKVA {
    static constexpr bool PERM = false, AFTER_DRAIN = false, PERM64 = false;
    bf16_t* CQ; bf16_t* CKV; float* QK; const float* gq; const float* gkv; float* ssq_q; float* ssq_kv; float* ssq_kp; const float* ssq; const float* bias; int ldbias;
    __device__ __forceinline__ void operator()(const f32x4 (&acc)[2][2][4][2], const Unit& u, int wr, int wc, int fr, int fq) const {
        const int row0 = u.pm * BM + wr * 64 + fr, col0 = u.pn * BM + wc * 32 + 4 * fq, lane = fq * 16 + fr;
        const bool fused = ssq != nullptr && u.pm < MLAT / BM;
        f32x4 bv[2][2], gg[2][2];
#pragma unroll
        for (int bj = 0; bj < 2; ++bj)
#pragma unroll
            for (int n = 0; n < 2; ++n) { const int c = col0 + bj * HALF + n * 16;
                bv[bj][n] = fused ? *(const f32x4*)(bias + (size_t)(u.pm >> 4) * ldbias + c) : (f32x4){0.f, 0.f, 0.f, 0.f};
                gg[bj][n] = c < QLORA ? *(const f32x4*)(gq + c) : (c < QLORA + KVLORA ? *(const f32x4*)(gkv + (c - QLORA)) : (f32x4){1.f, 1.f, 1.f, 1.f}); }
#pragma unroll
        for (int ai = 0; ai < 2; ++ai)
#pragma unroll
            for (int m = 0; m < 4; ++m) { const int row = row0 + ai * HALF + m * 16;
                const float rr = fused ? 1.0f / sqrtf(ssq[row] * (1.f / DM) + EPS) : 1.f;
                float sq = 0.f, skv = 0.f, skp = 0.f;
#pragma unroll
                for (int bj = 0; bj < 2; ++bj)
#pragma unroll
                    for (int n = 0; n < 2; ++n) { const int c = col0 + bj * HALF + n * 16; const f32x4 v = acc[ai][bj][m][n] * rr + bv[bj][n];
                        const float s2 = (v[0] * v[0] + v[1] * v[1]) + (v[2] * v[2] + v[3] * v[3]); const f32x4 h = v * gg[bj][n];
                        u32x2 w; w.x = cvt_pk_bf16(h[0], h[1]); w.y = cvt_pk_bf16(h[2], h[3]);
                        if (c < QLORA) { *(u32x2*)(CQ + (size_t)row * QLORA + c) = w; sq += s2; }
                        else if (c < QLORA + KVLORA) { *(u32x2*)(CKV + (size_t)row * KVLORA + (c - QLORA)) = w; skv += s2; }
                        else if (c < QLORA + KVLORA + QKR) { *(f32x4*)(QK + (size_t)row * NQKVA + c) = v; skp += s2; } }
                sq += shx(sq, 16, lane); sq += shx(sq, 32, lane); skv += shx(skv, 16, lane); skv += shx(skv, 32, lane);
                if (u.pn == 2 && wc < 2) { skp += shx(skp, 16, lane); skp += shx(skp, 32, lane); }
                if (fq == 0) { if (u.pn <= 1) atomicAdd(ssq_q + row, sq); if (u.pn >= 1) atomicAdd(ssq_kv + row, skv); if (u.pn == 2 && wc < 2) atomicAdd(ssq_kp + row, skp); } }
    }
};
struct EpiKV {
    static constexpr bool PERM = true, AFTER_DRAIN = false, PERM64 = false;
    bf16_t* KV; bf16_t* KPE; const float* QK; const float* ssq_kv; const float* ssq_kp; const float* kn; const float* rope; PG8_LAS float* scr;
    __device__ __forceinline__ void operator()(const f32x4 (&acc)[2][2][4][2], const Unit& u, int wr, int wc, int fr, int fq) const {
        const int h = u.pn, lane = fq * 16 + fr, rowl0 = wr * 64 + fr, row0 = u.pm * BM + rowl0, colk = wc * 32 + 8 * fq;
        float rl[2][4];
#pragma unroll
        for (int ai = 0; ai < 2; ++ai)
#pragma unroll
            for (int m = 0; m < 4; ++m) { rl[ai][m] = 1.0f / sqrtf(ssq_kv[row0 + ai * HALF + m * 16] * (1.f / KVLORA) + EPS);
                const f32x4 a0 = acc[ai][0][m][0] * rl[ai][m], a1 = acc[ai][0][m][1] * rl[ai][m];
                float s = ((a0[0] * a0[0] + a0[1] * a0[1]) + (a0[2] * a0[2] + a0[3] * a0[3])) + ((a1[0] * a1[0] + a1[1] * a1[1]) + (a1[2] * a1[2] + a1[3] * a1[3]));
                s += shx(s, 16, lane); s += shx(s, 32, lane);
                if (fq == 0) scr[(ai * HALF + rowl0 + m * 16) * 4 + wc] = s; }
        asm volatile("s_waitcnt lgkmcnt(0)" ::: "memory"); __builtin_amdgcn_s_barrier(); asm volatile("" ::: "memory");
        const f32x4 g0 = *(const f32x4*)(kn + colk), g1 = *(const f32x4*)(kn + colk + 4);
        const int dA = (wc >> 1) * 32 + (wc & 1) * 8 + 2 * fq, ff = (wc & 1) * 8 + 2 * fq;
        const f32x2 ga = *(const f32x2*)(kn + QKN + dA), gb = *(const f32x2*)(kn + QKN + dA + 16);
#pragma unroll
        for (int ai = 0; ai < 2; ++ai)
#pragma unroll
            for (int m = 0; m < 4; ++m) { const int row = row0 + ai * HALF + m * 16;
                const f32x4 p = *(const PG8_LAS f32x4*)(scr + (ai * HALF + rowl0 + m * 16) * 4);
                const float rinv = 1.0f / sqrtf((((p[0] + p[1]) + (p[2] + p[3])) + ssq_kp[row]) * (1.f / QKD) + EPS), ks = rl[ai][m] * rinv;
                bf16_t* kvp = KV + (size_t)row * (NH * 256) + h * 256 + colk;
                { const f32x4 k0 = acc[ai][0][m][0] * ks * g0, k1 = acc[ai][0][m][1] * ks * g1;
                  u32x4 w; w.x = cvt_pk_bf16(k0[0], k0[1]); w.y = cvt_pk_bf16(k0[2], k0[3]); w.z = cvt_pk_bf16(k1[0], k1[1]); w.w = cvt_pk_bf16(k1[2], k1[3]); *(u32x4*)kvp = w; }
                { const f32x4 v0 = acc[ai][1][m][0] * rl[ai][m], v1 = acc[ai][1][m][1] * rl[ai][m];
                  u32x4 w; w.x = cvt_pk_bf16(v0[0], v0[1]); w.y = cvt_pk_bf16(v0[2], v0[3]); w.z = cvt_pk_bf16(v1[0], v1[1]); w.w = cvt_pk_bf16(v1[2], v1[3]); *(u32x4*)(kvp + 128) = w; }
                const float* kp = QK + (size_t)row * NQKVA + (QLORA + KVLORA) + dA;
                const f32x2 ya = *(const f32x2*)kp * rinv * ga, yb = *(const f32x2*)(kp + 16) * rinv * gb;
                f32x2 cs = (f32x2){1.f, 1.f}, sn = (f32x2){0.f, 0.f};
                if (row < MLAT) { const int s = row & (SEQ - 1), pos = wc < 2 ? (s >> 6) : (s & 63); cs = *(const f32x2*)(rope + pos * 16 + ff); sn = *(const f32x2*)(rope + 1024 + pos * 16 + ff); }
                const f32x2 za = ya * cs - yb * sn, zb = yb * cs + ya * sn;
                bf16_t* pe = KPE + (size_t)row * (NH * QKR) + h * QKR + dA;
                *(unsigned*)pe = cvt_pk_bf16(za.x, za.y); *(unsigned*)(pe + 16) = cvt_pk_bf16(zb.x, zb.y); }
    }
};
struct EpiResidFuse {
    static constexpr bool PERM = false, AFTER_DRAIN = false, PERM64 = false;
    const float* src; float* dst; const float* gate; bf16_t* Hn; const float* gnext; const float* scn; float* ssq; PG8_LAS float* scr;
    __device__ __forceinline__ void operator()(const f32x4 (&acc)[2][2][4][2], const Unit& u, int wr, int wc, int fr, int fq) const {
        const int bidx = u.pm >> 4, row0 = u.pm * BM + wr * 64 + fr, col0 = u.pn * BM + wc * 32 + 4 * fq, lane = fq * 16 + fr;
        f32x4 gv[2][2], gs[2][2];
#pragma unroll
        for (int bj = 0; bj < 2; ++bj)
#pragma unroll
            for (int n = 0; n < 2; ++n) { const int c = col0 + bj * HALF + n * 16; gv[bj][n] = *(const f32x4*)(gate + (size_t)bidx * NMOD + c);
                gs[bj][n] = *(const f32x4*)(gnext + c) * (*(const f32x4*)(scn + (size_t)bidx * NMOD + c) + 1.0f); }
#pragma unroll
        for (int ai = 0; ai < 2; ++ai)
#pragma unroll
            for (int m = 0; m < 4; ++m) { const int row = row0 + ai * HALF + m * 16; const size_t off = (size_t)row * DM + col0; float ss = 0.f;
#pragma unroll
                for (int bj = 0; bj < 2; ++bj)
#pragma unroll
                    for (int n = 0; n < 2; ++n) { const f32x4 x = *(const f32x4*)(src + off + bj * HALF + n * 16) + gv[bj][n] * acc[ai][bj][m][n];
                        *(f32x4*)(dst + off + bj * HALF + n * 16) = x; ss += (x[0] * x[0] + x[1] * x[1]) + (x[2] * x[2] + x[3] * x[3]);
                        const f32x4 hh = x * gs[bj][n]; u32x2 w; w.x = cvt_pk_bf16(hh[0], hh[1]); w.y = cvt_pk_bf16(hh[2], hh[3]); *(u32x2*)(Hn + off + bj * HALF + n * 16) = w; }
                ss += shx(ss, 16, lane); ss += shx(ss, 32, lane);
                if (fq == 0) scr[(ai * HALF + wr * 64 + m * 16 + fr) * 4 + wc] = ss; }
        asm volatile("s_waitcnt lgkmcnt(0)" ::: "memory"); __builtin_amdgcn_s_barrier(); asm volatile("" ::: "memory");
        if (lane < 32) { const int rl = 32 * (wr * 4 + wc) + lane; const f32x4 p = *(const PG8_LAS f32x4*)(scr + rl * 4); atomicAdd(ssq + u.pm * BM + rl, (p[0] + p[1]) + (p[2] + p[3])); }
    }
};
struct EpiResid {
    static constexpr bool PERM = false, AFTER_DRAIN = false, PERM64 = false;
    const float* srcLat; const float* srcCtx; float* dstLat; float* dstCtx; const float* gate;
    __device__ __forceinline__ void operator()(const f32x4 (&acc)[2][2][4][2], const Unit& u, int wr, int wc, int fr, int fq) const {
        const bool lat = u.pm < MLAT / BM;
        const int rbase = lat ? u.pm * BM : u.pm * BM - MLAT, bidx = lat ? (u.pm >> 4) : 4;
        const float* src = lat ? srcLat : srcCtx; float* dst = lat ? dstLat : dstCtx;
        const int row0 = rbase + wr * 64 + fr, col0 = u.pn * BM + wc * 32 + 4 * fq;
        const float* gp = gate + (size_t)bidx * NMOD + col0;
        f32x4 gv[2][2];
#pragma unroll
        for (int bj = 0; bj < 2; ++bj)
#pragma unroll
            for (int n = 0; n < 2; ++n) gv[bj][n] = *(const f32x4*)(gp + bj * HALF + n * 16);
#pragma unroll
        for (int ai = 0; ai < 2; ++ai)
#pragma unroll
            for (int m = 0; m < 4; ++m) { const size_t off = (size_t)(row0 + ai * HALF + m * 16) * DM + col0;
#pragma unroll
                for (int bj = 0; bj < 2; ++bj)
#pragma unroll
                    for (int n = 0; n < 2; ++n) { const f32x4 s = *(const f32x4*)(src + off + bj * HALF + n * 16);
                        *(f32x4*)(dst + off + bj * HALF + n * 16) = s + gv[bj][n] * acc[ai][bj][m][n]; } }
    }
};
struct EpiSlab {
    static constexpr bool PERM = false, AFTER_DRAIN = false, PERM64 = false;
    float* slab; const float* gate;
    __device__ __forceinline__ void operator()(const f32x4 (&acc)[2][2][4][2], const Unit& u, int wr, int wc, int fr, int fq) const {
        const int row0 = u.pk * MCTX + (u.pm * BM - MLAT) + wr * 64 + fr, col0 = u.pn * BM + wc * 32 + 4 * fq;
        const float* gp = gate + (size_t)4 * NMOD + col0;
        f32x4 gv[2][2];
#pragma unroll
        for (int bj = 0; bj < 2; ++bj)
#pragma unroll
            for (int n = 0; n < 2; ++n) gv[bj][n] = *(const f32x4*)(gp + bj * HALF + n * 16);
#pragma unroll
        for (int ai = 0; ai < 2; ++ai)
#pragma unroll
            for (int m = 0; m < 4; ++m) { float* rowp = slab + (size_t)(row0 + ai * HALF + m * 16) * DM + col0;
#pragma unroll
                for (int bj = 0; bj < 2; ++bj)
#pragma unroll
                    for (int n = 0; n < 2; ++n) *(f32x4*)(rowp + bj * HALF + n * 16) = gv[bj][n] * acc[ai][bj][m][n]; }
    }
};
struct EpiGeluT {
    static constexpr bool PERM = true, AFTER_DRAIN = false, PERM64 = false;
    bf16_t* O; int ldc; float* S1; float* S2; const float* ssq; const float* bias; int ldbias;
    __device__ __forceinline__ void operator()(const f32x4 (&acc)[2][2][4][2], const Unit& u, int wr, int wc, int fr, int fq) const {
        const int row0 = u.pm * BM + wr * 64 + fr, col0 = u.pn * BM + wc * 32 + 8 * fq;
        const bool fused = ssq != nullptr && u.pn < MLAT / BM;
        f32x4 rv[2][2];
#pragma unroll
        for (int bj = 0; bj < 2; ++bj)
#pragma unroll
            for (int n = 0; n < 2; ++n) { if (fused) { const f32x4 q = *(const f32x4*)(ssq + col0 + bj * HALF + 4 * n);
#pragma unroll
                    for (int e = 0; e < 4; ++e) rv[bj][n][e] = 1.0f / sqrtf(q[e] * (1.f / DM) + EPS); } else rv[bj][n] = (f32x4){1.f, 1.f, 1.f, 1.f}; }
        f32x4 s1[2][2], s2[2][2];
#pragma unroll
        for (int bj = 0; bj < 2; ++bj)
#pragma unroll
            for (int n = 0; n < 2; ++n) { s1[bj][n] = (f32x4){0.f, 0.f, 0.f, 0.f}; s2[bj][n] = (f32x4){0.f, 0.f, 0.f, 0.f}; }
#pragma unroll
        for (int ai = 0; ai < 2; ++ai)
#pragma unroll
            for (int m = 0; m < 4; ++m) { bf16_t* rowp = O + (size_t)(row0 + ai * HALF + m * 16) * ldc + col0;
                const float bb = fused ? bias[(size_t)(u.pn >> 4) * ldbias + row0 + ai * HALF + m * 16] : 0.f;
#pragma unroll
                for (int bj = 0; bj < 2; ++bj) { const f32x4 v0 = act4(acc[ai][bj][m][0] * rv[bj][0] + bb, 1), v1 = act4(acc[ai][bj][m][1] * rv[bj][1] + bb, 1);
                    s1[bj][0] += v0; s1[bj][1] += v1; s2[bj][0] += v0 * v0; s2[bj][1] += v1 * v1;
                    u32x4 w; w.x = cvt_pk_bf16(v0[0], v0[1]); w.y = cvt_pk_bf16(v0[2], v0[3]); w.z = cvt_pk_bf16(v1[0], v1[1]); w.w = cvt_pk_bf16(v1[2], v1[3]);
                    *(u32x4*)(rowp + bj * HALF) = w; } }
        float my1 = 0.f, my2 = 0.f;
#pragma unroll
        for (int bj = 0; bj < 2; ++bj)
#pragma unroll
            for (int n = 0; n < 2; ++n)
#pragma unroll
                for (int e = 0; e < 4; ++e) { const float a = row16_sum(s1[bj][n][e]), b = row16_sum(s2[bj][n][e]);
                    const bool mine = fr == bj * 8 + n * 4 + e; my1 = mine ? a : my1; my2 = mine ? b : my2; }
        { const int col = col0 + (fr >> 3) * HALF + ((fr >> 2) & 1) * 4 + (fr & 3); atomicAdd(S1 + col, my1); atomicAdd(S2 + col, my2); }
    }
};
struct EpiGate {
    static constexpr bool PERM = true, AFTER_DRAIN = false, PERM64 = false;
    bf16_t* U; int ldc; const float* bs;
    __device__ __forceinline__ void operator()(const f32x4 (&acc)[2][2][4][2], const Unit& u, int wr, int wc, int fr, int fq) const {
        const int row0 = u.pm * BM + wr * 64 + fr, col0 = u.pn * BM + wc * 32 + 8 * fq;
#pragma unroll
        for (int ai = 0; ai < 2; ++ai)
#pragma unroll
            for (int m = 0; m < 4; ++m) { const int row = row0 + ai * HALF + m * 16; const float bias = bs[u.pn * 128 + (row & 127)];
                bf16_t* rowp = U + (size_t)row * ldc + col0;
#pragma unroll
                for (int bj = 0; bj < 2; ++bj) { const u32x4 uu = *(const u32x4*)(rowp + bj * HALF);
                    const f32x4 a0 = acc[ai][bj][m][0] + bias, a1 = acc[ai][bj][m][1] + bias;
                    u32x4 w; w.x = cvt_pk_bf16(bf_lo(uu.x) * a0[0], bf_hi(uu.x) * a0[1]); w.y = cvt_pk_bf16(bf_lo(uu.y) * a0[2], bf_hi(uu.y) * a0[3]);
                    w.z = cvt_pk_bf16(bf_lo(uu.z) * a1[0], bf_hi(uu.z) * a1[1]); w.w = cvt_pk_bf16(bf_lo(uu.w) * a1[2], bf_hi(uu.w) * a1[3]);
                    *(u32x4*)(rowp + bj * HALF) = w; } }
    }
};

template <class Epi, class Sched, bool ALIGN_EPI = false, bool SP2 = false>
__device__ __forceinline__ void gemm_phase(PG8_LAS unsigned char* lds, const Gemm g, const Sched& S, const Epi& E) {
    int tid_ = threadIdx.x; asm volatile("" : "+v"(tid_));
    const int tid = tid_, wid = __builtin_amdgcn_readfirstlane(tid >> 6), lane = tid & 63, wr = wid >> 2, wc = wid & 3, fr = lane & 15, fq = lane >> 4;
    const int K = g.K, nt = K / BK;
    unsigned voffA[2], voffB[2];
#pragma unroll
    for (int i = 0; i < 2; ++i) { int R, C; stage_rc(tid * 16 + i * 8192, R, C); const int Rb = Epi::PERM ? (Epi::PERM64 ? (64 * (R >> 5) + perm32(R & 31)) : ((R & ~31) + perm32(R & 31))) : R;
        voffA[i] = (unsigned)(R * g.lda + C) * 2u; voffB[i] = (unsigned)(Rb * g.ldb + C) * 2u; }
    const size_t kstep = (size_t)(BK * 2);
    const size_t hstepA = (size_t)HALF * g.lda * 2, hstepB = (size_t)(Epi::PERM64 ? 32 : HALF) * g.ldb * 2;
    const unsigned ldsw = (unsigned)wid * 1024u;
    const int aoff = lds_byte(wr * 64 + fr, fq * 8), boff = lds_byte(wc * 32 + fr, fq * 8);
#define PG8_SA(b, h) (((b) * 2 + (h)) * HTB)
#define PG8_SB(b, h) ((4 + (b) * 2 + (h)) * HTB)
#define PG8_STAGE(bufoff, gbase, voff) do { _Pragma("unroll") for (int _i = 0; _i < 2; ++_i) \
        __builtin_amdgcn_global_load_lds((const unsigned*)((const char*)(gbase) + (voff)[_i]), (PG8_LAS unsigned*)(lds + (bufoff) + ldsw + _i * 8192), 16, 0, 0); } while (0)
#define PG8_LDA(dst, b, h) do { _Pragma("unroll") for (int m = 0; m < 4; ++m) _Pragma("unroll") for (int k = 0; k < 2; ++k) dst[m][k] = *(const PG8_LAS bf16x8*)(lds + PG8_SA(b, h) + aoff + m * 2048 + k * 1024); } while (0)
#define PG8_LDB(dst, b, h) do { _Pragma("unroll") for (int n = 0; n < 2; ++n) _Pragma("unroll") for (int k = 0; k < 2; ++k) dst[n][k] = *(const PG8_LAS bf16x8*)(lds + PG8_SB(b, h) + boff + n * 2048 + k * 1024); } while (0)
#define PG8_MMA(ai, bj, At, Bt) do { __builtin_amdgcn_s_setprio(1); _Pragma("unroll") for (int m = 0; m < 4; ++m) _Pragma("unroll") for (int n = 0; n < 2; ++n) _Pragma("unroll") for (int k = 0; k < 2; ++k) \
        acc[ai][bj][m][n] = __builtin_amdgcn_mfma_f32_16x16x32_bf16(Bt[n][k], At[m][k], acc[ai][bj][m][n], 0, 0, 0); __builtin_amdgcn_s_setprio(0); } while (0)
#define PG8_WAIT_V(n) asm volatile("s_waitcnt vmcnt(" #n ")" ::: "memory")
#define PG8_WAIT_L(n) asm volatile("s_waitcnt lgkmcnt(" #n ")" ::: "memory")
#define PG8_BAR __builtin_amdgcn_s_barrier()
#define PG8_SCHED __builtin_amdgcn_sched_barrier(0)
    Unit cur, nxt; int ui = 0;
    if (!S.next(0, cur)) return;
    f32x4 acc[2][2][4][2];
#pragma unroll
    for (int a = 0; a < 2; ++a)
#pragma unroll
        for (int b = 0; b < 2; ++b)
#pragma unroll
            for (int m = 0; m < 4; ++m)
#pragma unroll
                for (int n = 0; n < 2; ++n) acc[a][b][m][n] = (f32x4){0.f, 0.f, 0.f, 0.f};
    bf16x8 At[4][2], B0[2][2], B1[2][2];
    const char* cA = g.a_of(cur); const char* cB = g.b_of(cur);
    S.a_ready(cur);
    if constexpr (SP2) {
        PG8_STAGE(PG8_SB(0, 0), cB, voffB); PG8_STAGE(PG8_SB(0, 1), cB + hstepB, voffB); PG8_STAGE(PG8_SA(0, 0), cA, voffA); PG8_STAGE(PG8_SA(0, 1), cA + hstepA, voffA);
        if (wr == 1) PG8_BAR;
        PG8_WAIT_V(2); PG8_BAR;
        PG8_STAGE(PG8_SB(1, 0), cB + kstep, voffB); PG8_STAGE(PG8_SA(1, 0), cA + kstep, voffA); PG8_STAGE(PG8_SB(1, 1), cB + hstepB + kstep, voffB);
        PG8_WAIT_V(6); PG8_BAR;
    } else {
        PG8_STAGE(PG8_SB(0, 0), cB, voffB); PG8_STAGE(PG8_SA(0, 0), cA, voffA); PG8_STAGE(PG8_SB(0, 1), cB + hstepB, voffB); PG8_STAGE(PG8_SA(0, 1), cA + hstepA, voffA);
        if (wr == 1) PG8_BAR;
        PG8_WAIT_V(4); PG8_BAR;
        PG8_STAGE(PG8_SB(1, 0), cB + kstep, voffB); PG8_STAGE(PG8_SA(1, 0), cA + kstep, voffA); PG8_STAGE(PG8_SB(1, 1), cB + hstepB + kstep, voffB);
        PG8_WAIT_V(6); PG8_BAR;
    }
    for (;;) {
        const bool has_next = S.next(ui + 1, nxt);
        const char* nA = has_next ? g.a_of(nxt) : cA; const char* nB = has_next ? g.b_of(nxt) : cB;
        for (int t = 0; t < nt; t += 2) {
            const bool last = (t == nt - 2);
            const char* a1 = cA + (size_t)(t + 1) * kstep;
            const char* a2 = last ? nA : cA + (size_t)(t + 2) * kstep; const char* b2 = last ? nB : cB + (size_t)(t + 2) * kstep;
            const char* a3 = a2 + kstep; const char* b3 = b2 + kstep;
            if (last && has_next) S.a_ready(nxt);
            if constexpr (SP2) {
            PG8_LDB(B0, 0, 0); PG8_LDB(B1, 0, 1); PG8_SCHED; PG8_LDA(At, 0, 0); PG8_STAGE(PG8_SA(1, 1), a1 + hstepA, voffA);
            PG8_WAIT_V(8); PG8_WAIT_L(0); PG8_BAR; PG8_MMA(0, 0, At, B0); PG8_MMA(0, 1, At, B1); PG8_BAR; PG8_SCHED;
            PG8_LDA(At, 0, 1); PG8_STAGE(PG8_SB(0, 0), b2, voffB); PG8_STAGE(PG8_SB(0, 1), b2 + hstepB, voffB); PG8_STAGE(PG8_SA(0, 0), a2, voffA);
            PG8_WAIT_V(8); PG8_WAIT_L(0); PG8_BAR; PG8_MMA(1, 0, At, B0); PG8_MMA(1, 1, At, B1); PG8_BAR; PG8_SCHED;
            PG8_LDB(B0, 1, 0); PG8_LDB(B1, 1, 1); PG8_SCHED; PG8_LDA(At, 1, 0); PG8_STAGE(PG8_SA(0, 1), a2 + hstepA, voffA);
            PG8_WAIT_V(8); PG8_WAIT_L(0); PG8_BAR; PG8_MMA(0, 0, At, B0); PG8_MMA(0, 1, At, B1); PG8_BAR; PG8_SCHED;
            PG8_LDA(At, 1, 1); PG8_STAGE(PG8_SB(1, 0), b3, voffB); PG8_STAGE(PG8_SB(1, 1), b3 + hstepB, voffB); PG8_STAGE(PG8_SA(1, 0), a3, voffA);
            PG8_WAIT_V(8); PG8_WAIT_L(0); PG8_BAR; PG8_MMA(1, 0, At, B0); PG8_MMA(1, 1, At, B1); PG8_BAR; PG8_SCHED;
            } else {
            PG8_LDB(B0, 0, 0); PG8_SCHED; PG8_LDA(At, 0, 0); PG8_STAGE(PG8_SA(1, 1), a1 + hstepA, voffA);
            PG8_WAIT_L(8); PG8_BAR; PG8_WAIT_L(0); PG8_MMA(0, 0, At, B0); PG8_BAR; PG8_SCHED;
            PG8_LDB(B1, 0, 1); PG8_STAGE(PG8_SB(0, 0), b2, voffB);
            PG8_BAR; PG8_WAIT_L(0); PG8_MMA(0, 1, At, B1); PG8_BAR;
            PG8_LDA(At, 0, 1); PG8_STAGE(PG8_SA(0, 0), a2, voffA);
            PG8_BAR; PG8_WAIT_L(0); PG8_MMA(1, 0, At, B0); PG8_BAR; PG8_SCHED;
            PG8_STAGE(PG8_SB(0, 1), b2 + hstepB, voffB);
            PG8_WAIT_V(6); PG8_BAR; PG8_MMA(1, 1, At, B1); PG8_BAR;
            PG8_LDB(B0, 1, 0); PG8_SCHED; PG8_LDA(At, 1, 0); PG8_STAGE(PG8_SA(0, 1), a2 + hstepA, voffA);
            PG8_WAIT_L(8); PG8_BAR; PG8_WAIT_L(0); PG8_MMA(0, 0, At, B0); PG8_BAR; PG8_SCHED;
            PG8_LDB(B1, 1, 1); PG8_STAGE(PG8_SB(1, 0), b3, voffB);
            PG8_BAR; PG8_WAIT_L(0); PG8_MMA(0, 1, At, B1); PG8_BAR;
            PG8_LDA(At, 1, 1); PG8_STAGE(PG8_SA(1, 0), a3, voffA);
            PG8_BAR; PG8_WAIT_L(0); PG8_MMA(1, 0, At, B0); PG8_BAR; PG8_SCHED;
            PG8_STAGE(PG8_SB(1, 1), b3 + hstepB, voffB);
            PG8_WAIT_V(6); PG8_BAR; PG8_MMA(1, 1, At, B1); PG8_BAR;
            }
        }
        if constexpr (ALIGN_EPI) { if (wr == 0) PG8_BAR; }
        if constexpr (!Epi::AFTER_DRAIN) { E(acc, cur, wr, wc, fr, fq); S.done(cur); }
        if (!has_next) break;
#pragma unroll
        for (int a = 0; a < 2; ++a)
#pragma unroll
            for (int b = 0; b < 2; ++b)
#pragma unroll
                for (int m = 0; m < 4; ++m)
#pragma unroll
                    for (int n = 0; n < 2; ++n) acc[a][b][m][n] = (f32x4){0.f, 0.f, 0.f, 0.f};
        cur = nxt; cA = nA; cB = nB; ++ui;
        if constexpr (ALIGN_EPI) { if (wr == 1) PG8_BAR; }
    }
    PG8_WAIT_V(0);
    if constexpr (!ALIGN_EPI) { if (wr == 0) PG8_BAR; }
    PG8_BAR;
    if constexpr (Epi::AFTER_DRAIN) { E.fused(acc, cur, wr, wc, fr, fq, lds, wid, lane); S.done(cur); }
#undef PG8_SA
#undef PG8_SB
#undef PG8_STAGE
#undef PG8_LDA
#undef PG8_LDB
#undef PG8_MMA
#undef PG8_WAIT_V
#undef PG8_WAIT_L
#undef PG8_BAR
#undef PG8_SCHED
}
}

__device__ __forceinline__ void unpack8(const u32x4 w, float* f) { f[0] = bf_lo(w.x); f[1] = bf_hi(w.x); f[2] = bf_lo(w.y); f[3] = bf_hi(w.y); f[4] = bf_lo(w.z); f[5] = bf_hi(w.z); f[6] = bf_lo(w.w); f[7] = bf_hi(w.w); }
__device__ __forceinline__ u32x4 pack8(const float* f) { u32x4 w; w.x = cvt_pk_bf16(f[0], f[1]); w.y = cvt_pk_bf16(f[2], f[3]); w.z = cvt_pk_bf16(f[4], f[5]); w.w = cvt_pk_bf16(f[6], f[7]); return w; }
namespace att {
using f32x16 = __attribute__((ext_vector_type(16))) float;
using s16x4  = __attribute__((ext_vector_type(4))) short;
constexpr int NW = 8, QBLK = 32, KVBLK = 64;
constexpr float SCALE = 0.072168783648703220f;
constexpr float THR = 8.f;
constexpr int LDQ = NH * QKD, LDKV = NH * 256, LDKP = NH * QKR, LDO = NH * VD;
constexpr int SHM_V = KVBLK * 128 * 2, SHM_KN = KVBLK * 128 * 2, SHM_KP = KVBLK * 64 * 2;
constexpr int OFF_V = 0, OFF_KN = 2 * SHM_V, OFF_KP = OFF_KN + 2 * SHM_KN, OFF_WS = OFF_KP + 2 * SHM_KP, SHM_ATTN = OFF_WS + NW * 64 * 4;
#define KSWZ(row, colB) ((row) * 256 + ((colB) ^ (((row) & 15) << 4)))
#define KPSWZ(row, colB) ((row) * 128 + ((colB) ^ ((((row) >> 1) & 7) << 4)))
#define SBAR() __builtin_amdgcn_sched_barrier(0)
__device__ __forceinline__ int crow(int r, int hi) { return (r & 3) + 8 * (r >> 2) + 4 * hi; }
__device__ __forceinline__ unsigned cvtpk(float lo, float hi) { unsigned r; asm volatile("v_cvt_pk_bf16_f32 %0, %1, %2" : "=v"(r) : "v"(lo), "v"(hi)); return r; }
__device__ __forceinline__ bf16x8 ld8(const bf16_t* p) { return *reinterpret_cast<const bf16x8*>(p); }

__device__ __forceinline__ void partialSM(f32x16& p0, f32x16& p1, float& m_reg, float& mn, float& alpha) {
  constexpr float C = SCALE * 1.4426950408889634f;
  float pmax = p0[0]; for (int r = 1; r < 16; ++r) pmax = fmaxf(pmax, p0[r]); for (int r = 0; r < 16; ++r) pmax = fmaxf(pmax, p1[r]);
  { auto rr = __builtin_amdgcn_permlane32_swap(__float_as_uint(pmax), __float_as_uint(pmax), false, false);
    pmax = fmaxf(__uint_as_float(rr[0]), __uint_as_float(rr[1])); }
  if (__builtin_expect(__all(pmax - m_reg <= THR / SCALE), 1)) { mn = m_reg; alpha = 1.f; }
  else { mn = fmaxf(m_reg, pmax); alpha = __builtin_amdgcn_exp2f((m_reg - mn) * C); m_reg = mn; }
  float mnC = -mn * C;
  for (int r = 0; r < 16; ++r) p0[r] = fmaf(p0[r], C, mnC); for (int r = 0; r < 16; ++r) p1[r] = fmaf(p1[r], C, mnC);
  for (int r = 0; r < 16; ++r) p0[r] = __builtin_amdgcn_exp2f(p0[r]);
}
__device__ __forceinline__ void finishSM(f32x16& p0, f32x16& p1, float alpha, float& l_reg, bf16x8& pa0, bf16x8& pa1, bf16x8& pa2, bf16x8& pa3) {
  for (int r = 0; r < 16; ++r) p1[r] = __builtin_amdgcn_exp2f(p1[r]);
  float ps = 0; for (int r = 0; r < 16; ++r) ps += p0[r]; for (int r = 0; r < 16; ++r) ps += p1[r];
  { auto rr = __builtin_amdgcn_permlane32_swap(__float_as_uint(ps), __float_as_uint(ps), false, false);
    ps = __uint_as_float(rr[0]) + __uint_as_float(rr[1]); }
  l_reg = l_reg * alpha + ps;
#define PK4(P, BASE, OUT) do { unsigned a0 = cvtpk(P[BASE + 0], P[BASE + 1]), a1 = cvtpk(P[BASE + 2], P[BASE + 3]);   \
    unsigned b0 = cvtpk(P[BASE + 4], P[BASE + 5]), b1 = cvtpk(P[BASE + 6], P[BASE + 7]);                              \
    auto r0 = __builtin_amdgcn_permlane32_swap(a0, b0, false, false); auto r1 = __builtin_amdgcn_permlane32_swap(a1, b1, false, false); \
    u32x4 w = {r0[0], r1[0], r0[1], r1[1]}; OUT = *reinterpret_cast<bf16x8*>(&w); } while (0)
  PK4(p0, 0, pa0); PK4(p0, 8, pa1); PK4(p1, 0, pa2); PK4(p1, 8, pa3);
#undef PK4
}
__device__ __forceinline__ void qkt(f32x16& p0, f32x16& p1, const char* Kn, const char* Kp, const bf16x8* qr, int r32, int hi) {
  p0 = f32x16{}; p1 = f32x16{};
#pragma unroll
  for (int d0 = 0; d0 < 8; ++d0) { int cb = (d0 * 16 + hi * 8) * 2;
    bf16x8 b0 = *reinterpret_cast<const bf16x8*>(Kn + KSWZ(r32, cb));
    bf16x8 b1 = *reinterpret_cast<const bf16x8*>(Kn + KSWZ(32 + r32, cb));
    p0 = __builtin_amdgcn_mfma_f32_32x32x16_bf16(b0, qr[d0], p0, 0, 0, 0);
    p1 = __builtin_amdgcn_mfma_f32_32x32x16_bf16(b1, qr[d0], p1, 0, 0, 0); }
#pragma unroll
  for (int d1 = 0; d1 < 4; ++d1) { int cb = (d1 * 16 + hi * 8) * 2;
    bf16x8 b0 = *reinterpret_cast<const bf16x8*>(Kp + KPSWZ(r32, cb));
    bf16x8 b1 = *reinterpret_cast<const bf16x8*>(Kp + KPSWZ(32 + r32, cb));
    p0 = __builtin_amdgcn_mfma_f32_32x32x16_bf16(b0, qr[8 + d1], p0, 0, 0, 0);
    p1 = __builtin_amdgcn_mfma_f32_32x32x16_bf16(b1, qr[8 + d1], p1, 0, 0, 0); }
}
__device__ __forceinline__ int v_st(int k, int c) { const int kk = (k & ~0xC) | ((k & 4) << 1) | ((k & 8) >> 1); return ((kk >> 3) * 4 + (c >> 5)) * 512 + ((kk & 7) * 32 + (c & 31)) * 2; }
__device__ __forceinline__ int v_rd_base(int lane) { return ((lane & 3) << 3) | (((lane >> 2) & 3) << 6) | (((lane >> 4) & 1) << 5) | (((lane >> 5) & 1) << 8); }
constexpr int v_rd_off(int d0, int ks, int half) { return d0 * 512 + ks * 4096 + half * 2048; }
template <int OFF> __device__ __forceinline__ s16x4 tr_read(int vb) {
  s16x4 r; asm volatile("ds_read_b64_tr_b16 %0, %1 offset:%2" : "=&v"(r) : "v"(vb), "i"(OFF) : "memory"); return r;
}
template <int D0> __device__ __forceinline__ void pv_one(f32x16& od, int vb, bf16x8 pa0, bf16x8 pa1, bf16x8 pa2, bf16x8 pa3) {
  const s16x4 l0 = tr_read<v_rd_off(D0, 0, 0)>(vb), h0 = tr_read<v_rd_off(D0, 0, 1)>(vb), l1 = tr_read<v_rd_off(D0, 1, 0)>(vb), h1 = tr_read<v_rd_off(D0, 1, 1)>(vb);
  const s16x4 l2 = tr_read<v_rd_off(D0, 2, 0)>(vb), h2 = tr_read<v_rd_off(D0, 2, 1)>(vb), l3 = tr_read<v_rd_off(D0, 3, 0)>(vb), h3 = tr_read<v_rd_off(D0, 3, 1)>(vb);
  asm volatile("s_waitcnt lgkmcnt(0)" ::: "memory"); SBAR();
#define PK(L, H) (bf16x8){L[0], L[1], L[2], L[3], H[0], H[1], H[2], H[3]}
  __builtin_amdgcn_s_setprio(1);
  od = __builtin_amdgcn_mfma_f32_32x32x16_bf16(pa0, PK(l0, h0), od, 0, 0, 0);
  od = __builtin_amdgcn_mfma_f32_32x32x16_bf16(pa1, PK(l1, h1), od, 0, 0, 0);
  od = __builtin_amdgcn_mfma_f32_32x32x16_bf16(pa2, PK(l2, h2), od, 0, 0, 0);
  od = __builtin_amdgcn_mfma_f32_32x32x16_bf16(pa3, PK(l3, h3), od, 0, 0, 0);
  __builtin_amdgcn_s_setprio(0);
#undef PK
}
__device__ __forceinline__ void pv_d0(f32x16* o, int vb, bf16x8 pa0, bf16x8 pa1, bf16x8 pa2, bf16x8 pa3) {
  pv_one<0>(o[0], vb, pa0, pa1, pa2, pa3); pv_one<1>(o[1], vb, pa0, pa1, pa2, pa3); pv_one<2>(o[2], vb, pa0, pa1, pa2, pa3); pv_one<3>(o[3], vb, pa0, pa1, pa2, pa3);
}

__device__ __forceinline__ void attn_unit(const bf16_t* __restrict__ Qb, const bf16_t* __restrict__ KV, const bf16_t* __restrict__ KP, bf16_t* __restrict__ Ob,
                                          int h, int qrow0, int ctx0, int lat0, int NT, char* lds, const float* __restrict__ qn, const float* __restrict__ rope, bool do_rope) {
  int tid_ = threadIdx.x; asm volatile("" : "+v"(tid_));
  const int tid = tid_, wid = tid >> 6, lane = tid & 63, r32 = lane & 31, hi = lane >> 5;
  char* V_lds = lds + OFF_V; char* KN_lds = lds + OFF_KN; char* KP_lds = lds + OFF_KP;
  float* ws = (float*)(lds + OFF_WS) + wid * 64; float* li_l = ws; float* al_l = ws + 32;
  float m_reg = -1e30f, l_reg = 0; f32x16 o[4] = {}; bf16x8 qr[12];
  const bf16_t* Qw = Qb + (size_t)(qrow0 + wid * QBLK + r32) * LDQ + h * QKD + hi * 8;
#pragma unroll
  for (int d0 = 0; d0 < 12; ++d0) qr[d0] = ld8(Qw + d0 * 16);
  {
    float qf[12][8]; float ss = 0.f;
#pragma unroll
    for (int d0 = 0; d0 < 12; ++d0) { const u32x4 w = *reinterpret_cast<const u32x4*>(&qr[d0]); unpack8(w, qf[d0]);
#pragma unroll
      for (int jj = 0; jj < 8; ++jj) ss += qf[d0][jj] * qf[d0][jj]; }
    { auto rr = __builtin_amdgcn_permlane32_swap(__float_as_uint(ss), __float_as_uint(ss), false, false); ss = __uint_as_float(rr[0]) + __uint_as_float(rr[1]); }
    const float rinv = 1.0f / sqrtf(ss * (1.f / QKD) + EPS);
#pragma unroll
    for (int d0 = 0; d0 < 12; ++d0) { const f32x4 g0 = *(const f32x4*)(qn + d0 * 16 + hi * 8), g1 = *(const f32x4*)(qn + d0 * 16 + hi * 8 + 4);
#pragma unroll
      for (int jj = 0; jj < 8; ++jj) qf[d0][jj] *= rinv * (jj < 4 ? g0[jj & 3] : g1[jj & 3]); }
    if (do_rope) { const int s = (qrow0 + wid * QBLK + r32) & (SEQ - 1), pr_ = s >> 6, pc_ = s & 63;
#pragma unroll
      for (int ax = 0; ax < 2; ++ax) { const float* cp = rope + (ax ? pc_ : pr_) * 16 + hi * 8; const f32x4 c0 = *(const f32x4*)cp, c1 = *(const f32x4*)(cp + 4), s0 = *(const f32x4*)(cp + 1024), s1 = *(const f32x4*)(cp + 1028);
#pragma unroll
        for (int jj = 0; jj < 8; ++jj) { const float c = jj < 4 ? c0[jj & 3] : c1[jj & 3], sn = jj < 4 ? s0[jj & 3] : s1[jj & 3], a = qf[8 + 2 * ax][jj], b = qf[9 + 2 * ax][jj];
          qf[8 + 2 * ax][jj] = a * c - b * sn; qf[9 + 2 * ax][jj] = b * c + a * sn; } } }
#pragma unroll
    for (int d0 = 0; d0 < 12; ++d0) { const u32x4 w = pack8(qf[d0]); qr[d0] = *reinterpret_cast<const bf16x8*>(&w); }
  }
  const int sr = tid >> 4, sc = (tid & 15) * 8, vst0 = v_st(sr, sc), vst1 = v_st(32 + sr, sc);
  const int pr = tid >> 3, pc = (tid & 7) * 8;
  const int vb0 = (int)(uintptr_t)V_lds + v_rd_base(lane);
  bf16x8 vs0, vs1, ks0, ks1, kp0;
  const bf16_t* KVh = KV + h * 256; const bf16_t* KPh = KP + h * QKR;
#define TROW(j) ((j) < 4 ? ctx0 + (j) * KVBLK : lat0 + ((j) - 4) * KVBLK)
#define SLOAD(j) do { const int r0_ = TROW(j); const bf16_t* a_ = KVh + (size_t)(r0_ + sr) * LDKV + sc; const bf16_t* b_ = KVh + (size_t)(r0_ + 32 + sr) * LDKV + sc; \
    vs0 = ld8(a_ + 128); vs1 = ld8(b_ + 128); ks0 = ld8(a_); ks1 = ld8(b_); kp0 = ld8(KPh + (size_t)(r0_ + pr) * LDKP + pc); } while (0)
#define SWRITE(b) do { *(bf16x8*)(V_lds + (b) * SHM_V + vst0) = vs0; *(bf16x8*)(V_lds + (b) * SHM_V + vst1) = vs1; const int kc = sc * 2; \
    *(bf16x8*)(KN_lds + (b) * SHM_KN + KSWZ(sr, kc)) = ks0; *(bf16x8*)(KN_lds + (b) * SHM_KN + KSWZ(32 + sr, kc)) = ks1; \
    *(bf16x8*)(KP_lds + (b) * SHM_KP + KPSWZ(pr, pc * 2)) = kp0; } while (0)
#define SWAIT() asm volatile("s_waitcnt vmcnt(0)" ::: "memory")
#define RESC(a) do { if (__any((a) < 1.f)) { if (hi == 0) al_l[r32] = (a); asm volatile("s_waitcnt lgkmcnt(0)" ::: "memory"); \
    for (int d = 0; d < 4; ++d) for (int r = 0; r < 16; ++r) o[d][r] *= al_l[crow(r, hi)]; } } while (0)
  f32x16 pA0, pA1, pB0, pB1; float mnA, mnB, alA, alB; bf16x8 pa0, pa1, pa2, pa3;
  SLOAD(0); SWAIT(); SWRITE(0); __syncthreads();
  qkt(pA0, pA1, KN_lds, KP_lds, qr, r32, hi); partialSM(pA0, pA1, m_reg, mnA, alA);
  SLOAD(1);
  SWAIT(); SWRITE(1); __syncthreads();
  for (int j = 1; j + 1 < NT; j += 2) {
    SBAR(); qkt(pB0, pB1, KN_lds + SHM_KN, KP_lds + SHM_KP, qr, r32, hi);
    finishSM(pA0, pA1, alA, l_reg, pa0, pa1, pa2, pa3); SBAR();
    SLOAD(j + 1); SBAR();
    pv_d0(o, vb0, pa0, pa1, pa2, pa3); partialSM(pB0, pB1, m_reg, mnB, alB);
    __syncthreads(); SWAIT(); SWRITE(0);
    RESC(alB); __syncthreads();
    SBAR(); qkt(pA0, pA1, KN_lds, KP_lds, qr, r32, hi);
    finishSM(pB0, pB1, alB, l_reg, pa0, pa1, pa2, pa3); SBAR();
    SLOAD(j + 2); SBAR();
    pv_d0(o, vb0 + SHM_V, pa0, pa1, pa2, pa3); partialSM(pA0, pA1, m_reg, mnA, alA);
    __syncthreads(); SWAIT(); SWRITE(1);
    RESC(alA); __syncthreads();
  }
  SBAR(); qkt(pB0, pB1, KN_lds + SHM_KN, KP_lds + SHM_KP, qr, r32, hi);
  finishSM(pA0, pA1, alA, l_reg, pa0, pa1, pa2, pa3); SBAR();
  pv_d0(o, vb0, pa0, pa1, pa2, pa3); partialSM(pB0, pB1, m_reg, mnB, alB);
  __syncthreads(); RESC(alB);
  finishSM(pB0, pB1, alB, l_reg, pa0, pa1, pa2, pa3); SBAR();
  pv_d0(o, vb0 + SHM_V, pa0, pa1, pa2, pa3);
  if (hi == 0) li_l[r32] = l_reg; asm volatile("s_waitcnt lgkmcnt(0)" ::: "memory");
  float rli[16];
#pragma unroll
  for (int r = 0; r < 16; ++r) rli[r] = __builtin_amdgcn_rcpf(li_l[crow(r, hi)]);
  bf16_t* Ow = Ob + (size_t)(qrow0 + wid * QBLK) * LDO + h * VD;
#pragma unroll
  for (int r = 0; r < 16; ++r) { const int orow = crow(r, hi);
#pragma unroll
    for (int d0 = 0; d0 < 4; ++d0) { const float v = o[d0][r] * rli[r]; Ow[(size_t)orow * LDO + d0 * 32 + r32] = (bf16_t)(cvtpk(v, v) & 0xffffu); } }
  __syncthreads();
#undef TROW
#undef SLOAD
#undef SWRITE
#undef SWAIT
#undef RESC
}
#undef SBAR
}

constexpr size_t MiB = 1u << 20;
constexpr size_t WS_CTL = 0;
constexpr size_t WS_BAR = 16384, CTL_ZERO_BYTES = 65536;
constexpr size_t WS_SSQL = 128 * 1024;
constexpr size_t WS_MOD = 1 * MiB;
constexpr size_t WS_ROPE = WS_MOD + 512 * 1024;
constexpr size_t WS_STAT = 2 * MiB;
constexpr size_t WS_SSQ = WS_STAT + 512 * 1024;
constexpr size_t WS_BIAS = WS_MOD + 576 * 1024;
constexpr size_t WS_XC = 3 * MiB;
constexpr size_t WS_W = 8 * MiB;
constexpr size_t WS_W1 = WS_W, WS_W2 = WS_W + 8 * MiB, W_FFN_STRIDE = 16 * MiB;
constexpr size_t WS_MLA = WS_W + 64 * MiB, W_MLA_STRIDE = 6 * MiB;
constexpr size_t OFF_WQKVA = 0, OFF_WQB = 3 * MiB / 2, OFF_WKVB = 11 * MiB / 4, OFF_WO = 4 * MiB;
constexpr size_t WS_GM = WS_MLA + 2 * W_MLA_STRIDE, W_GM_STRIDE = 13 * MiB;
constexpr size_t OFF_WIN = 0, OFF_WOUT = 8 * MiB, OFF_WBLK = 12 * MiB;
constexpr size_t WS_H = WS_GM + 2 * W_GM_STRIDE;
constexpr size_t WS_QKVA = WS_H + 34 * MiB;
constexpr size_t WS_CQ = WS_QKVA + 51 * MiB;
constexpr size_t WS_CKV = WS_CQ + 13 * MiB;
constexpr size_t WS_BIG = WS_CKV + 9 * MiB;
constexpr size_t OFF_QRAW = 0, OFF_KVRAW = 51 * MiB, OFF_KPE = 119 * MiB;
constexpr size_t OFF_FFH = 0;
constexpr size_t OFF_GU = 0, OFF_GVT = 68 * MiB;
constexpr size_t WS_END = WS_BIG + 136 * MiB;
static_assert(WS_H == 110 * MiB && WS_END == 353 * MiB, "ws map");

constexpr int LDS_BYTES = 147456;
static_assert(att::SHM_ATTN <= pg8::STAGE_BYTES, "attention LDS fits the GEMM ring");

struct Args { const float* in[25]; float* out; unsigned char* ws; int ph_lo, ph_hi; };
enum { I_X = 0, I_C, I_CTX, I_CCTX, I_ADAW, I_ADAB, I_NMG, I_NFG, I_WQA, I_QAN, I_WQB, I_WKVA, I_KVAN, I_WKVB, I_QN, I_KN, I_WO,
       I_GWIN, I_GLNG, I_GLNB, I_GWS, I_GBS, I_GWOUT, I_W1, I_W2 };
typedef const __attribute__((address_space(4))) Args* KArgsP;
struct KA {
    KArgsP p;
    __device__ __forceinline__ const float* in(int i) const { return p->in[i]; }
    __device__ __forceinline__ float* out() const { return p->out; }
    __device__ __forceinline__ unsigned char* ws() const { return p->ws; }
};

__device__ __forceinline__ unsigned f2bf(float f) { unsigned u = __builtin_bit_cast(unsigned, f); return (u + 0x7fffu + ((u >> 16) & 1u)) >> 16; }
__device__ __forceinline__ unsigned pk2(float lo, float hi) { return f2bf(lo) | (f2bf(hi) << 16); }

__device__ __forceinline__ void p0_transpose_item(const float* W, int K, int N, bf16_t* WT, int row_off, LAS float* scr, int item, int lane) {
    const int nblk = N / 64, kb = item / nblk, nb = item % nblk, k0 = 64 * kb, n0 = 64 * nb;
    const int kq = lane >> 4, n4 = (lane & 15) * 4;
    f32x4 v[16];
    const float* src = W + (size_t)(k0 + kq) * N + n0 + n4;
#pragma unroll
    for (int i = 0; i < 16; ++i) v[i] = __builtin_nontemporal_load((const f32x4*)(src + (size_t)(4 * i) * N));
#pragma unroll
    for (int i = 0; i < 16; ++i) { LAS float* d = scr + (4 * i + kq) * 65 + n4; d[0] = v[i].x; d[1] = v[i].y; d[2] = v[i].z; d[3] = v[i].w; }
    asm volatile("s_waitcnt lgkmcnt(0)" ::: "memory");
    const int c = lane & 7;
#pragma unroll
    for (int j = 0; j < 8; ++j) { const int n = (lane >> 3) + 8 * j; const LAS float* s = scr + (8 * c) * 65 + n;
        u32x4 o; o.x = cvt_pk_bf16(s[0 * 65], s[1 * 65]); o.y = cvt_pk_bf16(s[2 * 65], s[3 * 65]); o.z = cvt_pk_bf16(s[4 * 65], s[5 * 65]); o.w = cvt_pk_bf16(s[6 * 65], s[7 * 65]);
        *(u32x4*)(WT + (size_t)(row_off + n0 + n) * K + k0 + 8 * c) = o; }
    asm volatile("s_waitcnt lgkmcnt(0)" ::: "memory");
}

__device__ __forceinline__ void p0_phase(const KA a, unsigned char* ws, LAS unsigned char* lds, int bx, int G, int tid, int wave, int lane, int rep_ = 0) {
    LAS float* sil = (LAS float*)lds;
    LAS float* red = (LAS float*)(lds + 20480);
    for (int it = bx; it < 4 * 24; it += G) {
        const int l = it / 24, cg_ = it % 24, col0 = cg_ * 256;
        for (int i = tid; i < 5 * 1024; i += 512) { const int b = i >> 10, k = i & 1023; const float v = b < 4 ? a.in(I_C)[b * 1024 + k] : a.in(I_CCTX)[k]; sil[i] = v / (1.f + __expf(-v)); }
        __syncthreads();
        f32x4 acc[5];
#pragma unroll
        for (int b = 0; b < 5; ++b) acc[b] = (f32x4){0.f, 0.f, 0.f, 0.f};
        const float* W = a.in(I_ADAW) + (size_t)l * 1024 * NMOD + col0 + 4 * lane;
#pragma unroll 16
        for (int kk = 0; kk < 128; ++kk) { const int k = wave * 128 + kk; const f32x4 w = __builtin_nontemporal_load((const f32x4*)(W + (size_t)k * NMOD));
#pragma unroll
            for (int b = 0; b < 5; ++b) acc[b] += w * sil[b * 1024 + k]; }
#pragma unroll
        for (int b = 0; b < 5; ++b) *(LAS f32x4*)(red + (wave * 5 + b) * 256 + 4 * lane) = acc[b];
        __syncthreads();
        for (int i = tid; i < 5 * 256; i += 512) { const int b = i >> 8, c = i & 255; float s = a.in(I_ADAB)[l * NMOD + col0 + c];
#pragma unroll
            for (int w = 0; w < 8; ++w) s += red[(w * 5 + b) * 256 + c];
            ((float*)(ws + WS_MOD))[((size_t)l * 5 + b) * NMOD + col0 + c] = s; }
        __syncthreads();
    }
    const int gt = bx * 512 + tid, NT = G * 512;
    if (bx == G - 1) { for (int i = tid; i < 1024; i += 512) { const int pos = i >> 4, f = i & 15; const float inv = powf(10000.f, -(float)(2 * f) / 32.f), ang = (float)pos * inv;
        ((float*)(ws + WS_ROPE))[i] = cosf(ang); ((float*)(ws + WS_ROPE))[1024 + i] = sinf(ang); } }
    for (int i = gt; i < 2 * 2 * MALL; i += NT) ((float*)(ws + WS_STAT))[i] = 0.f;
    for (int i = gt; i < 8 * MLAT; i += NT) ((float*)(ws + WS_SSQ))[i] = 0.f;
    for (int i = gt; i < 6 * MALL; i += NT) ((float*)(ws + WS_CTL + WS_SSQL))[i] = 0.f;
    for (int i = gt; i < 2 * 64 * 1024 / 8; i += NT) { const int j = i / (64 * 1024 / 8), r = i % (64 * 1024 / 8);
        *(u32x4*)(ws + WS_MLA + j * W_MLA_STRIDE + OFF_WQKVA + (size_t)704 * 1024 * 2 + (size_t)r * 16) = (u32x4){0u, 0u, 0u, 0u}; }
    for (int i = gt; i < 2 * 8 * 256 * 256 / 2; i += NT) {
        const int e = i * 2, j = e / (8 * 65536), g = (e / 65536) % 8, rr = (e / 256) % 256, cc = e % 256;
        unsigned w = 0u;
        if ((rr >> 7) == (cc >> 7)) { const float* s = a.in(I_GWS) + (((size_t)j * 8 + g) * 128 + (rr & 127)) * 128 + (cc & 127); w = pk2(s[0], s[1]); }
        *(unsigned*)(ws + WS_GM + j * W_GM_STRIDE + OFF_WBLK + (size_t)(e % (8 * 65536)) * 2) = w; }
    LAS float* scr = (LAS float*)(lds + wave * 16640);
    unsigned* ctr = (unsigned*)(ws + WS_CTL) + 64 * rep_;
    constexpr int I_FF = 1024, I_QA = 96, I_KVA = 80, I_QB = 144, I_KVB = 128, I_OO = 256, I_MLA = I_QA + I_KVA + I_QB + I_KVB + I_OO, I_IN = 1024, I_OUT = 512, I_GMI = I_IN + I_OUT;
    constexpr int NITEMS = 4 * 2 * I_FF + 2 * I_MLA + 2 * I_GMI;
    static_assert(NITEMS % 4 == 0, "items are dequeued four at a time");
    for (int sub = 0, it0 = 0;; ++sub) {
        if ((sub & 3) == 0) { int t = 0; if (lane == 0) t = (int)atomicAdd(ctr, 4u); it0 = __builtin_amdgcn_readfirstlane(t); }
        int it = it0 + (sub & 3);
        if (it >= NITEMS) break;
        if (it < 4 * 2 * I_FF) { const int l = it / (2 * I_FF), r = it % (2 * I_FF);
            if (r < I_FF) p0_transpose_item(a.in(I_W1) + (size_t)l * DM * FFH, DM, FFH, (bf16_t*)(ws + WS_W1 + l * W_FFN_STRIDE), 0, scr, r, lane);
            else p0_transpose_item(a.in(I_W2) + (size_t)l * DM * FFH, FFH, DM, (bf16_t*)(ws + WS_W2 + l * W_FFN_STRIDE), 0, scr, r - I_FF, lane);
            continue; }
        it -= 4 * 2 * I_FF;
        if (it < 2 * I_MLA) { const int j = it / I_MLA; int r = it % I_MLA; unsigned char* wb = ws + WS_MLA + j * W_MLA_STRIDE;
            if (r < I_QA) { p0_transpose_item(a.in(I_WQA) + (size_t)j * DM * QLORA, DM, QLORA, (bf16_t*)(wb + OFF_WQKVA), 0, scr, r, lane); continue; } r -= I_QA;
            if (r < I_KVA) { p0_transpose_item(a.in(I_WKVA) + (size_t)j * DM * 320, DM, 320, (bf16_t*)(wb + OFF_WQKVA), 384, scr, r, lane); continue; } r -= I_KVA;
            if (r < I_QB) { p0_transpose_item(a.in(I_WQB) + (size_t)j * QLORA * 1536, QLORA, 1536, (bf16_t*)(wb + OFF_WQB), 0, scr, r, lane); continue; } r -= I_QB;
            if (r < I_KVB) { p0_transpose_item(a.in(I_WKVB) + (size_t)j * KVLORA * 2048, KVLORA, 2048, (bf16_t*)(wb + OFF_WKVB), 0, scr, r, lane); continue; } r -= I_KVB;
            p0_transpose_item(a.in(I_WO) + (size_t)j * DM * DM, DM, DM, (bf16_t*)(wb + OFF_WO), 0, scr, r, lane); continue; }
        it -= 2 * I_MLA;
        { const int j = it / I_GMI, r = it % I_GMI; unsigned char* wb = ws + WS_GM + j * W_GM_STRIDE;
            if (r < I_IN) p0_transpose_item(a.in(I_GWIN) + (size_t)j * DM * 4096, DM, 4096, (bf16_t*)(wb + OFF_WIN), 0, scr, r, lane);
            else p0_transpose_item(a.in(I_GWOUT) + (size_t)j * GMH * DM, GMH, DM, (bf16_t*)(wb + OFF_WOUT), 0, scr, r - I_IN, lane); }
    }
}

__device__ __forceinline__ void modulate_row(int r, const float* xlat, const float* xctx, const float* gain, const float* modl, int sh_off, int sc_off, bf16_t* H, int lane,
                                             const float* slab, int nslab, float* xc_out) {
    const bool lat = r < MLAT; const float* xr = lat ? xlat + (size_t)r * DM : xctx + (size_t)(r - MLAT) * DM; const int b = lat ? (r >> 12) : 4;
    const float* mp = modl + (size_t)b * NMOD;
    f32x4 v[4]; float s = 0.f;
#pragma unroll
    for (int j = 0; j < 4; ++j) v[j] = *(const f32x4*)(xr + 4 * lane + 256 * j);
    if (!lat && nslab > 0) {
        for (int t0 = 0; t0 < nslab; t0 += 4) {
            f32x4 sv[4][4];
#pragma unroll
            for (int t = 0; t < 4; ++t) { const float* sp = slab + ((size_t)(t0 + t) * MCTX + (r - MLAT)) * DM + 4 * lane;
#pragma unroll
                for (int j = 0; j < 4; ++j) sv[t][j] = *(const f32x4*)(sp + 256 * j); }
#pragma unroll
            for (int t = 0; t < 4; ++t)
#pragma unroll
                for (int j = 0; j < 4; ++j) v[j] += sv[t][j]; }
#pragma unroll
        for (int j = 0; j < 4; ++j) *(f32x4*)(xc_out + (size_t)(r - MLAT) * DM + 4 * lane + 256 * j) = v[j];
    }
#pragma unroll
    for (int j = 0; j < 4; ++j) s += (v[j].x * v[j].x + v[j].y * v[j].y) + (v[j].z * v[j].z + v[j].w * v[j].w);
    const float rinv = 1.0f / sqrtf(wave_sum(s, lane) * (1.f / DM) + EPS);
#pragma unroll
    for (int j = 0; j < 4; ++j) { const int c = 4 * lane + 256 * j; const f32x4 g = *(const f32x4*)(gain + c), sc = *(const f32x4*)(mp + sc_off + c), sh = *(const f32x4*)(mp + sh_off + c);
        const f32x4 y = (v[j] * rinv) * g * (sc + 1.0f) + sh;
        u32x2 w; w.x = cvt_pk_bf16(y[0], y[1]); w.y = cvt_pk_bf16(y[2], y[3]); *(u32x2*)(H + (size_t)r * DM + c) = w; }
}
template <int NR> __device__ __forceinline__ void modulate_rows(const int (&rows)[NR], const float* xlat, const float* xctx, const float* gain, const float* modl, int sh_off, int sc_off, bf16_t* H, int lane) {
    f32x4 v[NR][4]; float s[NR];
#pragma unroll
    for (int k = 0; k < NR; ++k) { const int r = rows[k]; const float* xr = r < MLAT ? xlat + (size_t)r * DM : xctx + (size_t)(r - MLAT) * DM;
#pragma unroll
        for (int j = 0; j < 4; ++j) v[k][j] = __builtin_nontemporal_load((const f32x4*)(xr + 4 * lane + 256 * j)); }
#pragma unroll
    for (int k = 0; k < NR; ++k) { s[k] = 0.f;
#pragma unroll
        for (int j = 0; j < 4; ++j) s[k] += (v[k][j].x * v[k][j].x + v[k][j].y * v[k][j].y) + (v[k][j].z * v[k][j].z + v[k][j].w * v[k][j].w); }
#pragma unroll
    for (int o = 1; o < 64; o <<= 1)
#pragma unroll
        for (int k = 0; k < NR; ++k) s[k] += shx(s[k], o, lane);
#pragma unroll
    for (int k = 0; k < NR; ++k) { const int r = rows[k]; const float rinv = 1.0f / sqrtf(s[k] * (1.f / DM) + EPS); const float* mp = modl + (size_t)(r < MLAT ? (r >> 12) : 4) * NMOD;
#pragma unroll
        for (int j = 0; j < 4; ++j) { const int c = 4 * lane + 256 * j; const f32x4 g = *(const f32x4*)(gain + c), sc = *(const f32x4*)(mp + sc_off + c), sh = *(const f32x4*)(mp + sh_off + c);
            const f32x4 y = (v[k][j] * rinv) * g * (sc + 1.0f) + sh;
            u32x2 w; w.x = cvt_pk_bf16(y[0], y[1]); w.y = cvt_pk_bf16(y[2], y[3]); *(u32x2*)(H + (size_t)r * DM + c) = w; } }
}
__device__ __forceinline__ void modulate_phase(const float* xlat, const float* xctx, const float* gain, const float* modl, int sh_off, int sc_off, bf16_t* H, int nrows, int gw, int NGW, int lane,
                                               const float* slab = nullptr, int nslab = 0, float* xc_out = nullptr) {
    if (nslab > 0 && nrows == MALL && NGW == 2048) {
        const int nA = nslab >= 8 ? 4 : 6, p = gw & 1023, i0 = gw < 1024 ? 0 : nA, i1 = gw < 1024 ? nA : 16;
        if (gw < 1024) modulate_row(MLAT + gw, xlat, xctx, gain, modl, sh_off, sc_off, H, lane, slab, nslab, xc_out);
        for (int i = i0; i < i1; i += 2) { const int rows[2] = {p * 16 + i, p * 16 + i + 1}; modulate_rows<2>(rows, xlat, xctx, gain, modl, sh_off, sc_off, H, lane); }
    } else if (nslab > 0) {
        for (int r = gw; r < nrows; r += NGW) modulate_row(r, xlat, xctx, gain, modl, sh_off, sc_off, H, lane, slab, nslab, xc_out);
    } else {
        int r = gw;
        for (; r + 3 * NGW < nrows; r += 4 * NGW) { const int rows[4] = {r, r + NGW, r + 2 * NGW, r + 3 * NGW}; modulate_rows<4>(rows, xlat, xctx, gain, modl, sh_off, sc_off, H, lane); }
        for (; r < nrows; r += NGW) { const int rows[1] = {r}; modulate_rows<1>(rows, xlat, xctx, gain, modl, sh_off, sc_off, H, lane); }
    }
}
__device__ __forceinline__ void modulate_ctx_phase(const float* xctx, const float* gain, const float* modl, int sh_off, int sc_off, bf16_t* H, int gw, int NGW, int lane, const float* slab, int nslab, float* xc_out) {
    for (int rr = gw; rr < MCTX; rr += NGW) modulate_row(MLAT + rr, nullptr, xctx, gain, modl, sh_off, sc_off, H, lane, slab, nslab, xc_out);
}
__device__ __forceinline__ void shift_bias_rows(const bf16_t* Wt, int nrows, const float* shift  , float* out, int ldo, int w0, int wstep, int lane) {
    f32x4 sh[4][4];
#pragma unroll
    for (int b = 0; b < 4; ++b)
#pragma unroll
        for (int q = 0; q < 4; ++q) sh[b][q] = *(const f32x4*)(shift + (size_t)b * NMOD + 16 * lane + 4 * q);
    for (int n0 = w0; n0 < nrows; n0 += 2 * wstep) {
        const int n1 = n0 + wstep; const bool has1 = n1 < nrows; const int n1c = has1 ? n1 : n0;
        float wv[2][16];
        unpack8(*(const u32x4*)(Wt + (size_t)n0 * DM + 16 * lane), wv[0]); unpack8(*(const u32x4*)(Wt + (size_t)n0 * DM + 16 * lane + 8), wv[0] + 8);
        unpack8(*(const u32x4*)(Wt + (size_t)n1c * DM + 16 * lane), wv[1]); unpack8(*(const u32x4*)(Wt + (size_t)n1c * DM + 16 * lane + 8), wv[1] + 8);
        float d[2][4];
#pragma unroll
        for (int u = 0; u < 2; ++u)
#pragma unroll
            for (int b = 0; b < 4; ++b) { float s = 0.f;
#pragma unroll
                for (int q = 0; q < 4; ++q) s += (sh[b][q][0] * wv[u][4 * q] + sh[b][q][1] * wv[u][4 * q + 1]) + (sh[b][q][2] * wv[u][4 * q + 2] + sh[b][q][3] * wv[u][4 * q + 3]);
                d[u][b] = s; }
#pragma unroll
        for (int o = 1; o < 64; o <<= 1)
#pragma unroll
            for (int u = 0; u < 2; ++u)
#pragma unroll
                for (int b = 0; b < 4; ++b) d[u][b] += shx(d[u][b], o, lane);
        if (lane < 4) { out[(size_t)lane * ldo + n0] = lane == 0 ? d[0][0] : lane == 1 ? d[0][1] : lane == 2 ? d[0][2] : d[0][3];
            if (has1) out[(size_t)lane * ldo + n1] = lane == 0 ? d[1][0] : lane == 1 ? d[1][1] : lane == 2 ? d[1][2] : d[1][3]; }
    }
}
__device__ __forceinline__ void lora_norm_phase(const float* qkva, const float* qan, const float* kvan, bf16_t* CQ, bf16_t* CKV, int nrows, int gw, int NGW, int lane) {
    for (int r = gw; r < nrows; r += NGW) {
        const float* p = qkva + (size_t)r * NQKVA;
        f32x2 q[3]; float s = 0.f;
#pragma unroll
        for (int j = 0; j < 3; ++j) { q[j] = *(const f32x2*)(p + 2 * lane + 128 * j); s += q[j].x * q[j].x + q[j].y * q[j].y; }
        const f32x4 kv = *(const f32x4*)(p + 384 + 4 * lane); const float s2 = (kv.x * kv.x + kv.y * kv.y) + (kv.z * kv.z + kv.w * kv.w);
        const float rq = 1.0f / sqrtf(wave_sum(s, lane) * (1.f / QLORA) + EPS), rk = 1.0f / sqrtf(wave_sum(s2, lane) * (1.f / KVLORA) + EPS);
#pragma unroll
        for (int j = 0; j < 3; ++j) { const int c = 2 * lane + 128 * j; const f32x2 g = *(const f32x2*)(qan + c); *(unsigned*)(CQ + (size_t)r * QLORA + c) = cvt_pk_bf16(q[j].x * rq * g.x, q[j].y * rq * g.y); }
        { const int c = 4 * lane; const f32x4 g = *(const f32x4*)(kvan + c); u32x2 w; w.x = cvt_pk_bf16(kv.x * rk * g.x, kv.y * rk * g.y); w.y = cvt_pk_bf16(kv.z * rk * g.z, kv.w * rk * g.w);
          *(u32x2*)(CKV + (size_t)r * KVLORA + c) = w; }
    }
}
__device__ __forceinline__ void qk_norm_rope_phase(bf16_t* Qraw, bf16_t* KVraw, bf16_t* KPE, const float* qkva, const float* qn, const float* kn, const float* rope, int nrows_q, int nrows, int gw, int NGW, int lane) {
    (void)Qraw; (void)qn; (void)nrows_q;
    const int h = lane >> 3, sub = lane & 7, fbase = (sub & 1) * 8;
    float gkn[16], gkp[8];
#pragma unroll
    for (int i = 0; i < 16; ++i) gkn[i] = kn[16 * sub + i];
#pragma unroll
    for (int i = 0; i < 8; ++i) gkp[i] = kn[128 + 8 * sub + i];
    for (int r0 = gw; r0 < nrows; r0 += 2 * NGW) {
        u32x4 xa[2][2]; f32x4 ka_[2][2], cv[2][2], sv[2][2]; int rr[2]; bool ok[2];
#pragma unroll
        for (int u = 0; u < 2; ++u) { const int r = r0 + u * NGW; ok[u] = r < nrows; rr[u] = ok[u] ? r : r0;
            const bf16_t* p = KVraw + (size_t)rr[u] * (NH * 256) + h * 256 + 16 * sub; xa[u][0] = *(const u32x4*)p; xa[u][1] = *(const u32x4*)(p + 8);
            const float* kp = qkva + (size_t)rr[u] * NQKVA + 640 + 8 * sub; ka_[u][0] = *(const f32x4*)kp; ka_[u][1] = *(const f32x4*)(kp + 4);
            const int s = rr[u] & (SEQ - 1), pos = (sub < 4) ? (s >> 6) : (s & 63); const float* cp = rope + pos * 16 + fbase;
            cv[u][0] = *(const f32x4*)cp; cv[u][1] = *(const f32x4*)(cp + 4); sv[u][0] = *(const f32x4*)(cp + 1024); sv[u][1] = *(const f32x4*)(cp + 1028); }
#pragma unroll
        for (int u = 0; u < 2; ++u) { if (!ok[u]) continue;
            const int r = rr[u]; const bool lat = r < MLAT;
            float x[16], y[8]; unpack8(xa[u][0], x); unpack8(xa[u][1], x + 8);
#pragma unroll
            for (int i = 0; i < 8; ++i) y[i] = ka_[u][i >> 2][i & 3];
            float ss = 0.f;
#pragma unroll
            for (int i = 0; i < 16; ++i) ss += x[i] * x[i];
#pragma unroll
            for (int i = 0; i < 8; ++i) ss += y[i] * y[i];
            ss += shx(ss, 1, lane); ss += shx(ss, 2, lane); ss += shx(ss, 4, lane);
            const float rinv = 1.0f / sqrtf(ss * (1.f / QKD) + EPS);
#pragma unroll
            for (int i = 0; i < 16; ++i) x[i] = x[i] * rinv * gkn[i];
            float z[8];
#pragma unroll
            for (int i = 0; i < 8; ++i) { y[i] = y[i] * rinv * gkp[i]; const float o = shx(y[i], 2, lane); const float c = lat ? cv[u][i >> 2][i & 3] : 1.f, sn = lat ? sv[u][i >> 2][i & 3] : 0.f;
                z[i] = y[i] * c + ((sub & 2) ? o : -o) * sn; }
            bf16_t* p = KVraw + (size_t)r * (NH * 256) + h * 256 + 16 * sub;
            *(u32x4*)p = pack8(x); *(u32x4*)(p + 8) = pack8(x + 8);
            *(u32x4*)(KPE + (size_t)r * (NH * QKR) + h * QKR + 8 * sub) = pack8(z); }
    }
}
__device__ __forceinline__ void gm_ln_phase(bf16_t* Vt, const float* S1, const float* S2, const float* lng, const float* lnb, int ntok, int gt, int NT) {
    const int per_row = ntok / 8, cstride = NT / per_row;
    const int tg = gt % per_row, c0 = gt / per_row;
    if (c0 >= cstride) return;
    const int t0 = tg * 8;
    float mu[8], rs[8];
    { const f32x4 a0 = *(const f32x4*)(S1 + t0), a1 = *(const f32x4*)(S1 + t0 + 4), b0 = *(const f32x4*)(S2 + t0), b1 = *(const f32x4*)(S2 + t0 + 4);
#pragma unroll
      for (int e = 0; e < 8; ++e) { const float s1 = e < 4 ? a0[e & 3] : a1[e & 3], s2 = e < 4 ? b0[e & 3] : b1[e & 3]; mu[e] = s1 * (1.f / GMH); rs[e] = 1.0f / sqrtf(fmaxf(s2 * (1.f / GMH) - mu[e] * mu[e], 0.f) + EPS); } }
    for (int c = c0; c < GMH; c += 4 * cstride) {
        u32x4 raw[4];
#pragma unroll
        for (int u = 0; u < 4; ++u) { const int cc = c + u * cstride; if (cc < GMH) raw[u] = *(const u32x4*)(Vt + (size_t)cc * MALL + t0); }
#pragma unroll
        for (int u = 0; u < 4; ++u) { const int cc = c + u * cstride; if (cc < GMH) { float x[8]; unpack8(raw[u], x); const float g = lng[cc], b = lnb[cc];
#pragma unroll
            for (int e = 0; e < 8; ++e) x[e] = (x[e] - mu[e]) * (rs[e] * g) + b;
            *(u32x4*)(Vt + (size_t)cc * MALL + t0) = pack8(x); } }
    }
}

__device__ __forceinline__ void gm_ln_block(bf16_t* Vt, const float* S1, const float* S2, const float* lng, const float* lnb, int c0, int t0, int tid) {
    const int tt = t0 + (tid & 31) * 8, r0 = tid >> 5;
    float mu[8], rs[8];
    { const f32x4 a0 = *(const f32x4*)(S1 + tt), a1 = *(const f32x4*)(S1 + tt + 4), b0 = *(const f32x4*)(S2 + tt), b1 = *(const f32x4*)(S2 + tt + 4);
#pragma unroll
      for (int e = 0; e < 8; ++e) { const float s1 = e < 4 ? a0[e & 3] : a1[e & 3], s2 = e < 4 ? b0[e & 3] : b1[e & 3]; mu[e] = s1 * (1.f / GMH); rs[e] = 1.0f / sqrtf(fmaxf(s2 * (1.f / GMH) - mu[e] * mu[e], 0.f) + EPS); } }
#pragma unroll
    for (int k0 = 0; k0 < 16; k0 += 8) {
        u32x4 raw[8];
#pragma unroll
        for (int k = 0; k < 8; ++k) raw[k] = *(const u32x4*)(Vt + (size_t)(c0 + r0 + 16 * (k0 + k)) * MALL + tt);
#pragma unroll
        for (int k = 0; k < 8; ++k) { const int c = c0 + r0 + 16 * (k0 + k); float x[8]; unpack8(raw[k], x); const float g = lng[c], b = lnb[c];
#pragma unroll
            for (int e = 0; e < 8; ++e) x[e] = (x[e] - mu[e]) * (rs[e] * g) + b;
            *(u32x4*)(Vt + (size_t)c * MALL + tt) = pack8(x); }
    }
}

#define XB_TMO      128
#define XB_XCNT(j)  (256  + 64 * (j))
#define XB_XSUB(j)  (1280 + 64 * (j))
#define XB_XGEN(j)  (2304 + 64 * (j))
#define XB_TOP      3328
#define XB_TOPGEN   3392
#define XCD_BAR_WORDS 3456
#define XB_SPIN_CAP (1u << 18)

__device__ __forceinline__ unsigned xb_ld(unsigned* p)              { return __hip_atomic_load(p, __ATOMIC_RELAXED, __HIP_MEMORY_SCOPE_AGENT); }
__device__ __forceinline__ unsigned xb_add(unsigned* p, unsigned v) { return __hip_atomic_fetch_add(p, v, __ATOMIC_RELAXED, __HIP_MEMORY_SCOPE_AGENT); }
__device__ __forceinline__ unsigned xb_xcc_id() { return (unsigned)__builtin_amdgcn_s_getreg((3 << 11) | 20) & 0xFu; }
#define XB_SPIN(cond, bar) do { unsigned _sp = 0; while (cond) { __builtin_amdgcn_s_sleep(1); \
    if ((++_sp & 255u) == 0u) { if (xb_ld(&(bar)[XB_TMO])) break; if (_sp > XB_SPIN_CAP) { atomicAdd(&(bar)[XB_TMO], 1u); break; } } } } while (0)

struct XcdBarrier {
    unsigned* bar; unsigned x;
    volatile LAS unsigned* st;
};

__device__ __forceinline__ XcdBarrier xcd_barrier_post(unsigned* bar, volatile LAS unsigned* st) {
    XcdBarrier b; b.bar = bar; b.x = xb_xcc_id(); b.st = st;
    if (threadIdx.x == 0) (void)xb_add(&bar[XB_XCNT(b.x)], 1u);
    return b;
}
__device__ __forceinline__ void xcd_barrier_complete(unsigned* bar, unsigned x, unsigned& nloc, unsigned& nx) {
    const unsigned G = gridDim.x * gridDim.y * gridDim.z;
    unsigned sum, cnt, mine, sp = 0u;
    for (;;) {
        sum = 0u; cnt = 0u; mine = 0u;
#pragma unroll
        for (unsigned j = 0; j < 16; ++j) { const unsigned c = xb_ld(&bar[XB_XCNT(j)]); sum += c; cnt += (c > 0u) ? 1u : 0u; mine = (j == x) ? c : mine; }
        if (sum == G) break;
        __builtin_amdgcn_s_sleep(1);
        if ((++sp & 255u) == 0u) { if (xb_ld(&bar[XB_TMO])) break; if (sp > XB_SPIN_CAP) { atomicAdd(&bar[XB_TMO], 1u); break; } }
    }
    nloc = mine > 0u ? mine : 1u; nx = cnt > 0u ? cnt : 1u;
}

__device__ __forceinline__ void xcd_barrier(const XcdBarrier& b) {
    asm volatile("s_waitcnt vmcnt(0)" ::: "memory");
    __syncthreads();
    if (threadIdx.x == 0) {
        unsigned* bar = b.bar;
        __builtin_amdgcn_s_waitcnt(0);
        unsigned nloc = b.st[0], nx = b.st[1];
        if (nloc == 0u) { xcd_barrier_complete(bar, b.x, nloc, nx); b.st[0] = nloc; b.st[1] = nx; }
        const unsigned old = xb_add(&bar[XB_XSUB(b.x)], 1u);
        const unsigned gen = old / nloc;
        if (old + 1u == (gen + 1u) * nloc) {
            __builtin_amdgcn_fence(__ATOMIC_RELEASE, "agent");
            asm volatile("s_waitcnt vmcnt(0)" ::: "memory");
            const unsigned og = xb_add(&bar[XB_TOP], 1u);
            const unsigned tg = og / nx;
            if (og + 1u == (tg + 1u) * nx) xb_add(&bar[XB_TOPGEN], 1u);
            else XB_SPIN(xb_ld(&bar[XB_TOPGEN]) == tg, bar);
            __builtin_amdgcn_fence(__ATOMIC_ACQUIRE, "agent");
            xb_add(&bar[XB_XGEN(b.x)], 1u);
            asm volatile("s_waitcnt vmcnt(0)" ::: "memory");
        } else {
            XB_SPIN(xb_ld(&bar[XB_XGEN(b.x)]) == gen, bar);
            __builtin_amdgcn_fence(__ATOMIC_ACQUIRE, "agent");
            asm volatile("s_waitcnt vmcnt(0)" ::: "memory");
        }
    }
    __syncthreads();
}

__global__ void __launch_bounds__(512, 2) fwd_mega(Args a_unused) {
    extern __shared__ __attribute__((aligned(16))) unsigned char lds_raw[];
    LAS unsigned char* lds = (LAS unsigned char*)lds_raw;
    cg::grid_group grid = cg::this_grid();
    const KArgsP ap0 = (KArgsP)__builtin_amdgcn_kernarg_segment_ptr();
    const int lo = ap0->ph_lo, hi = ap0->ph_hi;
    int ph = 0;
    volatile LAS unsigned* bst = (volatile LAS unsigned*)(lds + LDS_BYTES - 64);
    if (threadIdx.x < 2) bst[threadIdx.x] = 0u;
    __syncthreads();
    if (hi - lo > 1) (void)xcd_barrier_post((unsigned*)(ap0->ws + WS_CTL + WS_BAR), bst);
#define PHASE_BEGIN if (lo <= ph && ph < hi) { int tid = threadIdx.x; asm volatile("" : "+v"(tid));   \
    KA ka; { KArgsP ap_ = ap0; asm volatile("" : "+s"(ap_)); ka.p = ap_; } unsigned char* const ws = ka.ws(); \
    int G = gridDim.x, bx = blockIdx.x; asm volatile("" : "+s"(G), "+s"(bx)); \
    const int vcu = (G % 8 == 0) ? (bx % 8) * (G / 8) + bx / 8 : bx;       \
    const int NGW = G * 8, NTH = G * 512; \
    const int lane = tid & 63, wave = __builtin_amdgcn_readfirstlane(tid >> 6), gw = vcu * 8 + wave, gt = bx * 512 + tid; (void)lane; (void)wave; (void)gw; (void)gt; (void)ws; (void)NGW; (void)NTH;
#define PHASE_END   if (ph + 1 < hi) { if (hi > 4096) grid.sync();   else { XcdBarrier xb_; xb_.bar = (unsigned*)(ws + WS_CTL + WS_BAR); xb_.x = xb_xcc_id(); xb_.st = bst; for (int rb_ = 0; rb_ < REP_BAR; ++rb_) xcd_barrier(xb_); } } } ++ph;
#define XLAT ((l == 0) ? ka.in(I_X) : (const float*)ka.out())
#define XCTX ((l == 0) ? ka.in(I_CTX) : (const float*)(ws + WS_XC))
#define XC_ ((float*)(ws + WS_XC))
#define MODL ((const float*)(ws + WS_MOD) + (size_t)l * 5 * NMOD)
#define HB_ ((bf16_t*)(ws + WS_H))
#define WB_MLA (ws + WS_MLA + j * W_MLA_STRIDE)
#define WB_GM (ws + WS_GM + j * W_GM_STRIDE)
#define QKVA_ ((float*)(ws + WS_QKVA))
#define CQ_ ((bf16_t*)(ws + WS_CQ))
#define CKV_ ((bf16_t*)(ws + WS_CKV))
#define QRAW_ ((bf16_t*)(ws + WS_BIG + OFF_QRAW))
#define KVRAW_ ((bf16_t*)(ws + WS_BIG + OFF_KVRAW))
#define KPE_ ((bf16_t*)(ws + WS_BIG + OFF_KPE))
#define GU_ ((bf16_t*)(ws + WS_BIG + OFF_GU))
#define GVT_ ((bf16_t*)(ws + WS_BIG + OFF_GVT))
#define S1_ ((float*)(ws + WS_STAT) + (size_t)j * 2 * MALL)
#define S2_ (S1_ + MALL)
#define FH_ ((bf16_t*)(ws + WS_BIG + OFF_FFH))
#define SSQQ_ ((float*)(ws + WS_CTL + WS_SSQL) + (size_t)j * 2 * MALL)
#define SSQKV_ (SSQQ_ + MALL)
#define SSQKP_ ((float*)(ws + WS_CTL + WS_SSQL) + (size_t)(4 + j) * MALL)
#define O_ ((bf16_t*)(ws + WS_QKVA + 16 * MiB))
#define SSQ_(ll, which) ((float*)(ws + WS_SSQ) + (size_t)(2 * (ll) + (which)) * MLAT)
#define BIAS_F(ll) ((float*)(ws + WS_BIAS) + (size_t)(ll) * 4 * FFH)
#define BIAS_M(ll) ((float*)(ws + WS_BIAS) + (size_t)16 * FFH + ((ll) == 1 ? 0 : (ll) == 3 ? 4 * FFH : 8 * FFH))
#define MODN ((const float*)(ws + WS_MOD) + (size_t)(l + 1) * 5 * NMOD)
#define SLAB_ ((float*)(ws + WS_QKVA))

#define CTX_SPLIT_GEMM(Aptr, KTOT, Wptr, NSPLIT, GATEOFF) do { pg8::Gemm g2 = pg8::plain_gemm(Aptr, KTOT, Wptr, KTOT, (KTOT) / (NSPLIT)); g2.sAk = (size_t)((KTOT) / (NSPLIT)) * 2; g2.sBk = g2.sAk; \
    pg8::SplitOrder S2; S2.init(NSPLIT, G, G - 1 - bx); pg8::EpiSlab E2{SLAB_, MODL + (GATEOFF)}; pg8::gemm_phase<pg8::EpiSlab, pg8::SplitOrder, true, true>(lds, g2, S2, E2); } while (0)
    PHASE_BEGIN
#ifndef NO_P0
    for (int rep_ = 0; rep_ < REP_P0; ++rep_) { p0_phase(ka, ws, lds, bx, G, tid, wave, lane, rep_); __syncthreads(); }
#endif
    PHASE_END

    for (int l = 0; l < DEPTH; ++l) {
        const int j = l >> 1;
        const bool mla = (l & 1) == 0;
        const int Mrows = (l <= 2) ? MALL : MLAT;
        const int Mres = (l <= 1) ? MALL : MLAT;
        if (mla) {
            const int Mq = (l == 0) ? MALL : MLAT;
            PHASE_BEGIN
            if (l == 0) { modulate_phase(XLAT, XCTX, ka.in(I_NMG) + l * DM, MODL, 0, DM, HB_, Mrows, gw, NGW, lane);
                const float* mods = (const float*)(ws + WS_MOD);
                for (int ll = 0; ll < DEPTH; ++ll) shift_bias_rows((const bf16_t*)(ws + WS_W1 + ll * W_FFN_STRIDE), FFH, mods + (size_t)ll * 5 * NMOD + 3 * DM, (float*)(ws + WS_BIAS) + (size_t)ll * 4 * FFH, FFH, gw, NGW, lane);
                shift_bias_rows((const bf16_t*)(ws + WS_GM + 0 * W_GM_STRIDE + OFF_WIN), 2 * GMH, mods + (size_t)1 * 5 * NMOD, (float*)(ws + WS_BIAS) + (size_t)16 * FFH, 2 * GMH, gw, NGW, lane);
                shift_bias_rows((const bf16_t*)(ws + WS_GM + 1 * W_GM_STRIDE + OFF_WIN), 2 * GMH, mods + (size_t)3 * 5 * NMOD, (float*)(ws + WS_BIAS) + (size_t)16 * FFH + 4 * FFH, 2 * GMH, gw, NGW, lane);
                shift_bias_rows((const bf16_t*)(ws + WS_MLA + 1 * W_MLA_STRIDE + OFF_WQKVA), NQKVA, mods + (size_t)2 * 5 * NMOD, (float*)(ws + WS_BIAS) + (size_t)16 * FFH + 8 * FFH, NQKVA, gw, NGW, lane);
            } else modulate_ctx_phase(XCTX, ka.in(I_NMG) + l * DM, MODL, 0, DM, HB_, gw, NGW, lane, SLAB_, 8, XC_);
            PHASE_END
            PHASE_BEGIN for (int rep_ = 0; rep_ < REP_M24; ++rep_) { pg8::Gemm g = pg8::plain_gemm(HB_, DM, (const bf16_t*)(WB_MLA + OFF_WQKVA), DM, DM); pg8::StaticOrder S; S.init(Mrows, NQKVA, G, bx);
                pg8::EpiQKVA E{CQ_, CKV_, QKVA_, ka.in(I_QAN) + j * QLORA, ka.in(I_KVAN) + j * KVLORA, SSQQ_, SSQKV_, SSQKP_, l == 0 ? nullptr : SSQ_(l - 1, 1), BIAS_M(l), NQKVA}; pg8::gemm_phase<pg8::EpiQKVA, pg8::StaticOrder, true, true>(lds, g, S, E); } PHASE_END
            PHASE_BEGIN for (int rep_ = 0; rep_ < REP_M24; ++rep_) { { pg8::Gemm g = pg8::plain_gemm(CQ_, QLORA, (const bf16_t*)(WB_MLA + OFF_WQB), QLORA, QLORA); pg8::StaticOrder S; S.init(Mq, NH * QKD, G, bx);
                  pg8::EpiBf16<0> E{QRAW_, NH * QKD, SSQQ_, nullptr, 0, 1.f / QLORA, true}; pg8::gemm_phase<pg8::EpiBf16<0>, pg8::StaticOrder, true, true>(lds, g, S, E); }
                { pg8::Gemm g = pg8::plain_gemm(CKV_, KVLORA, (const bf16_t*)(WB_MLA + OFF_WKVB), KVLORA, KVLORA); pg8::StaticOrder S; S.init(Mrows, NH * 256, G, G - 1 - bx);
                  pg8::EpiKV E{KVRAW_, KPE_, QKVA_, SSQKV_, SSQKP_, ka.in(I_KN) + j * QKD, (const float*)(ws + WS_ROPE), (LAS float*)(lds + 131072)}; pg8::gemm_phase<pg8::EpiKV, pg8::StaticOrder, true, true>(lds, g, S, E); } } PHASE_END
            PHASE_BEGIN {
#ifndef NO_ATT
                for (int rep_ = 0; rep_ < REP_ATT; ++rep_)
                for (int u = vcu; u < NB * NH * (SEQ / 256); u += G) { const int bh = u >> 4, qb = u & 15, b = bh >> 3, h = bh & 7;
                    att::attn_unit(QRAW_, KVRAW_, KPE_, O_, h, b * SEQ + qb * 256, MLAT + b * CTX, b * SEQ, (CTX + SEQ) / 64, (char*)lds_raw, ka.in(I_QN) + j * QKD, (const float*)(ws + WS_ROPE), true); }
                if (l == 0) for (int u = vcu; u < NB * NH; u += G) { const int b = u >> 3, h = u & 7;
                    att::attn_unit(QRAW_, KVRAW_, KPE_, O_, h, MLAT + b * CTX, MLAT + b * CTX, 0, CTX / 64, (char*)lds_raw, ka.in(I_QN) + j * QKD, (const float*)(ws + WS_ROPE), false); }
#endif
            } PHASE_END
            PHASE_BEGIN { { pg8::Gemm g = pg8::plain_gemm(O_, DM, (const bf16_t*)(WB_MLA + OFF_WO), DM, DM); pg8::StaticOrder S; S.init(MLAT, DM, G, bx);
                pg8::EpiResidFuse E{XLAT, ka.out(), MODL + 2 * DM, HB_, ka.in(I_NFG) + l * DM, MODL + 4 * DM, SSQ_(l, 0), (LAS float*)(lds + 131072)}; pg8::gemm_phase<pg8::EpiResidFuse, pg8::StaticOrder, true, true>(lds, g, S, E); }
                if (Mres > MLAT) CTX_SPLIT_GEMM(O_, DM, (const bf16_t*)(WB_MLA + OFF_WO), 4, 2 * DM); } PHASE_END
        } else {
            if (l == 1) { PHASE_BEGIN modulate_ctx_phase(XCTX, ka.in(I_NMG) + l * DM, MODL, 0, DM, HB_, gw, NGW, lane, SLAB_, 8, XC_); PHASE_END }
            PHASE_BEGIN for (int rep_ = 0; rep_ < REP_G2; ++rep_) { { pg8::Gemm g = pg8::plain_gemm(HB_, DM, (const bf16_t*)(WB_GM + OFF_WIN), DM, DM); pg8::StaticOrder S; S.init(Mres, GMH, G, bx);
                  pg8::EpiBf16<1> E{GU_, GMH, SSQ_(l - 1, 1), BIAS_M(l), 2 * GMH, 1.f / DM, false}; pg8::gemm_phase<pg8::EpiBf16<1>, pg8::StaticOrder, true, true>(lds, g, S, E); }
                { pg8::Gemm g = pg8::plain_gemm((const bf16_t*)(WB_GM + OFF_WIN) + (size_t)GMH * DM, DM, HB_, DM, DM); pg8::StaticOrder S; S.init(GMH, Mres, G, G - 1 - bx);
                  pg8::EpiGeluT E{GVT_, MALL, S1_, S2_, SSQ_(l - 1, 1), BIAS_M(l) + GMH, 2 * GMH}; pg8::gemm_phase<pg8::EpiGeluT, pg8::StaticOrder, true, true>(lds, g, S, E); } } PHASE_END
            PHASE_BEGIN { pg8::Gemm g; g.A = (const char*)(WB_GM + OFF_WBLK); g.B = (const char*)GVT_; g.lda = 256; g.ldb = MALL; g.K = 256;
                g.sAm = 0; g.sAn = (size_t)256 * 256 * 2; g.sBm = (size_t)256 * 2; g.sBn = (size_t)256 * MALL * 2;
                pg8::StaticOrder S; S.init(Mres, GMH, G, bx);
                { pg8::Unit uu; for (int i = 0; S.next(i, uu); ++i) gm_ln_block(GVT_, S1_, S2_, ka.in(I_GLNG) + j * GMH, ka.in(I_GLNB) + j * GMH, uu.pn * 256, uu.pm * 256, tid);
                  asm volatile("s_waitcnt vmcnt(0)" ::: "memory"); __builtin_amdgcn_fence(__ATOMIC_ACQUIRE, "agent"); asm volatile("s_waitcnt vmcnt(0)" ::: "memory"); __syncthreads(); }
                pg8::EpiGate E{GU_, GMH, ka.in(I_GBS) + j * 8 * 128}; pg8::gemm_phase<pg8::EpiGate, pg8::StaticOrder, true, true>(lds, g, S, E); } PHASE_END
            PHASE_BEGIN { { pg8::Gemm g = pg8::plain_gemm(GU_, GMH, (const bf16_t*)(WB_GM + OFF_WOUT), GMH, GMH); pg8::StaticOrder S; S.init(MLAT, DM, G, bx);
                pg8::EpiResidFuse E{XLAT, ka.out(), MODL + 2 * DM, HB_, ka.in(I_NFG) + l * DM, MODL + 4 * DM, SSQ_(l, 0), (LAS float*)(lds + 131072)}; pg8::gemm_phase<pg8::EpiResidFuse, pg8::StaticOrder, true, true>(lds, g, S, E); }
                if (Mres > MLAT) CTX_SPLIT_GEMM(GU_, GMH, (const bf16_t*)(WB_GM + OFF_WOUT), 8, 2 * DM); } PHASE_END
        }
        if (l <= 1) { PHASE_BEGIN modulate_ctx_phase(XCTX, ka.in(I_NFG) + l * DM, MODL, 3 * DM, 4 * DM, HB_, gw, NGW, lane, SLAB_, l == 0 ? 4 : 8, XC_); PHASE_END }
        PHASE_BEGIN for (int rep_ = 0; rep_ < REP_F2; ++rep_) { pg8::Gemm g = pg8::plain_gemm(HB_, DM, (const bf16_t*)(ws + WS_W1 + l * W_FFN_STRIDE), DM, DM); pg8::StaticOrder S; S.init(Mres, FFH, G, bx);
            pg8::EpiBf16<2> E{FH_, FFH, SSQ_(l, 0), BIAS_F(l), FFH, 1.f / DM, false}; pg8::gemm_phase<pg8::EpiBf16<2>, pg8::StaticOrder, true, true>(lds, g, S, E); } PHASE_END
        PHASE_BEGIN { if (l >= 2) for (int rep_ = 0; rep_ < REP_F3X; ++rep_) { pg8::Gemm g = pg8::plain_gemm(FH_, FFH, (const bf16_t*)(ws + WS_W2 + l * W_FFN_STRIDE), FFH, FFH); pg8::StaticOrder S; S.init(MLAT, DM, G, bx);
            pg8::EpiBf16<0> E{(bf16_t*)(ws + WS_QKVA), DM, nullptr, nullptr, 0, 1.f, false}; pg8::gemm_phase<pg8::EpiBf16<0>, pg8::StaticOrder, true, true>(lds, g, S, E); }
 { pg8::Gemm g = pg8::plain_gemm(FH_, FFH, (const bf16_t*)(ws + WS_W2 + l * W_FFN_STRIDE), FFH, FFH); pg8::StaticOrder S; S.init(MLAT, DM, G, bx);
            if (l < DEPTH - 1) { pg8::EpiResidFuse E{ka.out(), ka.out(), MODL + 5 * DM, HB_, ka.in(I_NMG) + (l + 1) * DM, MODN + DM, SSQ_(l, 1), (LAS float*)(lds + 131072)}; pg8::gemm_phase<pg8::EpiResidFuse, pg8::StaticOrder, true, true>(lds, g, S, E); }
            else { pg8::EpiResid E{ka.out(), XC_, ka.out(), XC_, MODL + 5 * DM}; pg8::gemm_phase<pg8::EpiResid, pg8::StaticOrder, true, true>(lds, g, S, E); } }
            if (Mres > MLAT) CTX_SPLIT_GEMM(FH_, FFH, (const bf16_t*)(ws + WS_W2 + l * W_FFN_STRIDE), 8, 5 * DM); } PHASE_END
    }
#undef PHASE_BEGIN
#undef PHASE_END
}
constexpr int NPHASES = 1 + 8 + 7 + 7 + 5;

extern "C" void kernel_launch(void* const* d_in, const int* in_sizes, int n_in, void* d_out, int out_size, void* d_ws, size_t ws_size, hipStream_t stream) {
    static int grid = 0;
    if (grid == 0) {
        if (n_in != 25 || out_size != MLAT * DM || ws_size < WS_END) { fprintf(stderr, "kernel_launch: unexpected shapes: n_in %d out %d ws %zu (need %zu)\n", n_in, out_size, ws_size, (size_t)WS_END); grid = -1; return; }
        int dev = 0, cus = 0, per_cu = 0;
        hipGetDevice(&dev); hipDeviceGetAttribute(&cus, hipDeviceAttributeMultiprocessorCount, dev);
        if (hipFuncSetAttribute((const void*)fwd_mega, hipFuncAttributeMaxDynamicSharedMemorySize, LDS_BYTES) != hipSuccess) { fprintf(stderr, "kernel_launch: hipFuncSetAttribute failed\n"); grid = -1; return; }
        hipOccupancyMaxActiveBlocksPerMultiprocessor(&per_cu, (const void*)fwd_mega, 512, LDS_BYTES);
        (void)hipGetLastError();
        if (per_cu < 1) per_cu = 1;
        grid = cus * per_cu;
        fprintf(stderr, "kernel_launch: cus %d per_cu %d grid %d\n", cus, per_cu, grid);
    }
    if (grid < 0) return;
    (void)hipMemsetAsync((char*)d_ws + WS_CTL, 0, CTL_ZERO_BYTES, stream);
    Args a{};
    for (int i = 0; i < 25; ++i) a.in[i] = (const float*)d_in[i];
    a.out = (float*)d_out; a.ws = (unsigned char*)d_ws;
#if ONE_LAUNCH
    a.ph_lo = 0; a.ph_hi = NPHASES;
    void* args[] = {&a};
    hipError_t e = hipLaunchCooperativeKernel((const void*)fwd_mega, dim3(grid), dim3(512), args, LDS_BYTES, stream);
    if (e != hipSuccess) fprintf(stderr, "kernel_launch: cooperative launch failed: %s (grid %d)\n", hipGetErrorString(e), grid);
#else
    for (int p = 0; p < NPHASES; ++p) { a.ph_lo = p; a.ph_hi = p + 1; hipLaunchKernelGGL(fwd_mega, dim3(grid), dim3(512), LDS_BYTES, stream, a); }
    hipError_t e = hipPeekAtLastError();
    if (e != hipSuccess) fprintf(stderr, "kernel_launch: launch failed: %s\n", hipGetErrorString(e));
#endif
}
```

```cpp
#include <hip/hip_runtime.h>
#include <hip/hip_cooperative_groups.h>
#include <hip/hip_bf16.h>
#include <cstdio>
#include <cstdint>
namespace cg = cooperative_groups;

#ifndef ONE_LAUNCH
#define ONE_LAUNCH 1
#endif
#ifndef REP_ATT
#define REP_ATT 1
#endif
#ifndef REP_F2
#define REP_F2 1
#endif
#ifndef REP_P0
#define REP_P0 1
#endif
#ifndef REP_G2
#define REP_G2 1
#endif
#ifndef REP_M3
#define REP_M3 1
#endif
#ifndef REP_MOD
#define REP_MOD 1
#endif
#ifndef REP_BAR
#define REP_BAR 1
#endif
#ifndef REP_M24
#define REP_M24 1
#endif
#ifndef REP_F3X
#define REP_F3X 0
#endif

constexpr int DM = 1024, NB = 4, SEQ = 4096, CTX = 256, DEPTH = 4;
constexpr int MLAT = NB * SEQ, MCTX = NB * CTX, MALL = MLAT + MCTX;
constexpr int NH = 8, QKN = 128, QKR = 64, VD = 128, QKD = 192, QLORA = 384, KVLORA = 256;
constexpr int NQKVA = 768;
constexpr int GMH = 2048, FFH = 4096, NMOD = 6 * DM;
constexpr float EPS = 1e-6f;

#define LAS __attribute__((address_space(3)))
typedef unsigned short bf16_t;
typedef short bf16x8 __attribute__((ext_vector_type(8)));
typedef float f32x4 __attribute__((ext_vector_type(4)));
typedef float f32x2 __attribute__((ext_vector_type(2)));
typedef unsigned u32x4 __attribute__((ext_vector_type(4)));
typedef unsigned u32x2 __attribute__((ext_vector_type(2)));

__device__ __forceinline__ unsigned cvt_pk_bf16(float lo, float hi) { unsigned r; asm volatile("v_cvt_pk_bf16_f32 %0, %1, %2" : "=v"(r) : "v"(lo), "v"(hi)); return r; }
__device__ __forceinline__ float bf_lo(unsigned w) { return __uint_as_float(w << 16); }
__device__ __forceinline__ float bf_hi(unsigned w) { return __uint_as_float(w & 0xffff0000u); }
__device__ __forceinline__ float shx(float v, int o, int lane) { return __int_as_float(__builtin_amdgcn_ds_bpermute((lane ^ o) << 2, __float_as_int(v))); }
template <int N> __device__ __forceinline__ float dpp_ror(float v) { return __int_as_float(__builtin_amdgcn_update_dpp(0, __float_as_int(v), 0x120 + N, 0xf, 0xf, true)); }
__device__ __forceinline__ float row16_sum(float v) { v += dpp_ror<8>(v); v += dpp_ror<4>(v); v += dpp_ror<2>(v); v += dpp_ror<1>(v); return v; }
__device__ __forceinline__ float wave_sum(float v, int lane) {
#pragma unroll
    for (int o = 1; o < 64; o <<= 1) v += shx(v, o, lane);
    return v;
}

namespace pg8 {
#define PG8_LAS __attribute__((address_space(3)))
constexpr int BM = 256, BK = 64, HALF = 128, HTB = HALF * BK * 2  , STAGE_BYTES = 8 * HTB, NXCD = 8, WGM = 8;

__host__ __device__ __forceinline__ int lds_byte(int r, int c) { const int st = (r >> 4) * 2 + (c >> 5), rr = r & 15, cc = c & 31, ob = rr * 64 + cc * 2; return st * 1024 + (ob ^ (((ob >> 9) & 1) << 5)); }
__host__ __device__ __forceinline__ void stage_rc(int b, int& R, int& C) { const int st = b / 1024, sb = b % 1024, swz = sb ^ (((sb >> 9) & 1) << 5); R = (st >> 1) * 16 + swz / 64; C = (st & 1) * 32 + (swz % 64) / 2; }
__host__ __device__ __forceinline__ int perm32(int rho) { const int n = rho >> 4, i = rho & 15; return 8 * (i >> 2) + 4 * n + (i & 3); }

struct Unit { int pm, pn, pk; };
struct Gemm {
    const char* A; const char* B; int lda, ldb, K; size_t sAm, sAn, sBm, sBn, sAk, sBk;
    __device__ __forceinline__ const char* a_of(const Unit& u) const { return A + (size_t)u.pm * sAm + (size_t)u.pn * sAn + (size_t)u.pk * sAk; }
    __device__ __forceinline__ const char* b_of(const Unit& u) const { return B + (size_t)u.pm * sBm + (size_t)u.pn * sBn + (size_t)u.pk * sBk; }
};
__device__ __forceinline__ Gemm plain_gemm(const bf16_t* A, int lda, const bf16_t* Bt, int ldb, int K) {
    Gemm g; g.A = (const char*)A; g.B = (const char*)Bt; g.lda = lda; g.ldb = ldb; g.K = K;
    g.sAm = (size_t)BM * lda * 2; g.sAn = 0; g.sBm = 0; g.sBn = (size_t)BM * ldb * 2; g.sAk = 0; g.sBk = 0; return g;
}

struct StaticOrder {
    int nM, nN, nwg, G, c;
    __host__ __device__ __forceinline__ void init(int M, int N, int G_, int c_) { nM = M / BM; nN = N / BM; nwg = nM * nN; G = G_; c = c_; }
    __host__ __device__ __forceinline__ bool next(int i, Unit& u) const {
        const long L = (long)i * G + c; if (L >= nwg) return false;
        int wgid = (int)L; { const int q = nwg / NXCD, r = nwg % NXCD, xcd = wgid % NXCD, off = wgid / NXCD; wgid = (xcd < r ? xcd * (q + 1) : r * (q + 1) + (xcd - r) * q) + off; }
        const int nig = WGM * nN, gid = wgid / nig, fm = gid * WGM, gsz = (nM - fm) < WGM ? (nM - fm) : WGM;
        u.pm = fm + ((wgid % nig) % gsz); u.pn = (wgid % nig) / gsz; u.pk = 0; return true;
    }
    __device__ __forceinline__ void a_ready(const Unit&) const {}
    __device__ __forceinline__ void done(const Unit&) const {}
};

struct SplitOrder {
    int nsub, G, c;
    __device__ __forceinline__ void init(int nsplit, int G_, int c_) { nsub = 16 * nsplit; G = G_; c = c_; }
    __device__ __forceinline__ bool next(int i, Unit& u) const { const int L = i * G + c; if (L >= nsub) return false; u.pk = L >> 4; u.pm = MLAT / BM + (L & 3); u.pn = (L >> 2) & 3; return true; }
    __device__ __forceinline__ void a_ready(const Unit&) const {}
    __device__ __forceinline__ void done(const Unit&) const {}
};

__device__ __forceinline__ f32x2 gelu_pk(f32x2 v) {
    const f32x2 av = __builtin_elementwise_abs(v), d = av * 0.2316418882f + 1.0f;
    f32x2 t; t.x = __builtin_amdgcn_rcpf(d.x); t.y = __builtin_amdgcn_rcpf(d.y);
    f32x2 q = t * 0.5307027145f + (-0.7265760135f); q = q * t + 0.7107068705f; q = q * t + (-0.142248368f); q = q * t + 0.127414796f; q = q * t;
    const f32x2 s = (v * v) * (-0.72134752044f);
    f32x2 e; e.x = __builtin_amdgcn_exp2f(s.x); e.y = __builtin_amdgcn_exp2f(s.y);
    const f32x2 m = v * (q * e), r = v - m;
    f32x2 o; o.x = v.x < 0.f ? m.x : r.x; o.y = v.y < 0.f ? m.y : r.y; return o;
}
__device__ __forceinline__ f32x4 act4(f32x4 v, int act) {
    if (act == 1) { f32x2 a = gelu_pk((f32x2){v[0], v[1]}), b = gelu_pk((f32x2){v[2], v[3]}); return (f32x4){a.x, a.y, b.x, b.y}; }
    if (act == 2) { f32x4 r; for (int i = 0; i < 4; ++i) { const float t = fmaxf(v[i], 0.f); r[i] = t * t; } return r; }
    return v;
}


template <int ACT> struct EpiBf16 {
    static constexpr bool PERM = true, AFTER_DRAIN = false, PERM64 = true;
    bf16_t* O; int ldc; const float* ssq; const float* bias; int ldbias; float inv_n; bool all_rows;
    __device__ __forceinline__ void operator()(const f32x4 (&acc)[2][2][4][2], const Unit& u, int wr, int wc, int fr, int fq) const {
        const int row0 = u.pm * BM + wr * 64 + fr, col0 = u.pn * BM + wc * 64 + 8 * fq;
        const bool fused = ssq != nullptr && (all_rows || u.pm < MLAT / BM);
        f32x4 bv[2][2];
#pragma unroll
        for (int bj = 0; bj < 2; ++bj)
#pragma unroll
            for (int n = 0; n < 2; ++n) bv[bj][n] = (fused && bias != nullptr) ? *(const f32x4*)(bias + (size_t)(u.pm >> 4) * ldbias + col0 + bj * 32 + 4 * n) : (f32x4){0.f, 0.f, 0.f, 0.f};
#pragma unroll
        for (int ai = 0; ai < 2; ++ai)
#pragma unroll
            for (int m = 0; m < 4; ++m) { bf16_t* rowp = O + (size_t)(row0 + ai * HALF + m * 16) * ldc + col0;
                const float rr = fused ? __builtin_amdgcn_rsqf(ssq[row0 + ai * HALF + m * 16] * inv_n + EPS) : 1.f;
#pragma unroll
                for (int bj = 0; bj < 2; ++bj) { const f32x4 v0 = act4(acc[ai][bj][m][0] * rr + bv[bj][0], ACT), v1 = act4(acc[ai][bj][m][1] * rr + bv[bj][1], ACT);
                    u32x4 w; w.x = cvt_pk_bf16(v0[0], v0[1]); w.y = cvt_pk_bf16(v0[2], v0[3]); w.z = cvt_pk_bf16(v1[0], v1[1]); w.w = cvt_pk_bf16(v1[2], v1[3]);
                    *(u32x4*)(rowp + bj * 32) = w; } }
    }
};
struct EpiF32 {
    static constexpr bool PERM = false, AFTER_DRAIN = false, PERM64 = false;
    float* O; int ldc; const float* ssq; const float* bias; int ldbias;
    __device__ __forceinline__ void operator()(const f32x4 (&acc)[2][2][4][2], const Unit& u, int wr, int wc, int fr, int fq) const {
        const int row0 = u.pm * BM + wr * 64 + fr, col0 = u.pn * BM + wc * 32 + 4 * fq;
        const bool fused = ssq != nullptr && u.pm < MLAT / BM;
        f32x4 bv[2][2];
#pragma unroll
        for (int bj = 0; bj < 2; ++bj)
#pragma unroll
            for (int n = 0; n < 2; ++n) bv[bj][n] = fused ? *(const f32x4*)(bias + (size_t)(u.pm >> 4) * ldbias + col0 + bj * HALF + n * 16) : (f32x4){0.f, 0.f, 0.f, 0.f};
#pragma unroll
        for (int ai = 0; ai < 2; ++ai)
#pragma unroll
            for (int m = 0; m < 4; ++m) { float* rowp = O + (size_t)(row0 + ai * HALF + m * 16) * ldc + col0;
                const float rr = fused ? __builtin_amdgcn_rsqf(ssq[row0 + ai * HALF + m * 16] * (1.f / DM) + EPS) : 1.f;
#pragma unroll
                for (int bj = 0; bj < 2; ++bj)
#pragma unroll
                    for (int n = 0; n < 2; ++n) *(f32x4*)(rowp + bj * HALF + n * 16) = acc[ai][bj][m][n] * rr + bv[bj][n]; }
    }
};
struct EpiQKVA {
    static constexpr bool PERM = false, AFTER_DRAIN = false, PERM64 = false;
    bf16_t* CQ; bf16_t* CKV; float* QK; const float* gq; const float* gkv; float* ssq_q; float* ssq_kv; float* ssq_kp; const float* ssq; const float* bias; int ldbias;
    __device__ __forceinline__ void operator()(const f32x4 (&acc)[2][2][4][2], const Unit& u, int wr, int wc, int fr, int fq) const {
        const int row0 = u.pm * BM + wr * 64 + fr, col0 = u.pn * BM + wc * 32 + 4 * fq, lane = fq * 16 + fr;
        const bool fused = ssq != nullptr && u.pm < MLAT / BM;
        f32x4 bv[2][2], gg[2][2];
#pragma unroll
        for (int bj = 0; bj < 2; ++bj)
#pragma unroll
            for (int n = 0; n < 2; ++n) { const int c = col0 + bj * HALF + n * 16;
                bv[bj][n] = fused ? *(const f32x4*)(bias + (size_t)(u.pm >> 4) * ldbias + c) : (f32x4){0.f, 0.f, 0.f, 0.f};
                gg[bj][n] = c < QLORA ? *(const f32x4*)(gq + c) : (c < QLORA + KVLORA ? *(const f32x4*)(gkv + (c - QLORA)) : (f32x4){1.f, 1.f, 1.f, 1.f}); }
#pragma unroll
        for (int ai = 0; ai < 2; ++ai)
#pragma unroll
            for (int m = 0; m < 4; ++m) { const int row = row0 + ai * HALF + m * 16;
                const float rr = fused ? __builtin_amdgcn_rsqf(ssq[row] * (1.f / DM) + EPS) : 1.f;
                float sq = 0.f, skv = 0.f, skp = 0.f;
#pragma unroll
                for (int bj = 0; bj < 2; ++bj)
#pragma unroll
                    for (int n = 0; n < 2; ++n) { const int c = col0 + bj * HALF + n * 16; const f32x4 v = acc[ai][bj][m][n] * rr + bv[bj][n];
                        const float s2 = (v[0] * v[0] + v[1] * v[1]) + (v[2] * v[2] + v[3] * v[3]); const f32x4 h = v * gg[bj][n];
                        u32x2 w; w.x = cvt_pk_bf16(h[0], h[1]); w.y = cvt_pk_bf16(h[2], h[3]);
                        if (c < QLORA) { *(u32x2*)(CQ + (size_t)row * QLORA + c) = w; sq += s2; }
                        else if (c < QLORA + KVLORA) { *(u32x2*)(CKV + (size_t)row * KVLORA + (c - QLORA)) = w; skv += s2; }
                        else if (c < QLORA + KVLORA + QKR) { *(f32x4*)(QK + (size_t)row * NQKVA + c) = v; skp += s2; } }
                sq += shx(sq, 16, lane); sq += shx(sq, 32, lane); skv += shx(skv, 16, lane); skv += shx(skv, 32, lane);
                if (u.pn == 2 && wc < 2) { skp += shx(skp, 16, lane); skp += shx(skp, 32, lane); }
                if (fq == 0) { if (u.pn <= 1) atomicAdd(ssq_q + row, sq); if (u.pn >= 1) atomicAdd(ssq_kv + row, skv); if (u.pn == 2 && wc < 2) atomicAdd(ssq_kp + row, skp); } }
    }
};
struct EpiKV {
    static constexpr bool PERM = true, AFTER_DRAIN = false, PERM64 = false;
    bf16_t* KV; bf16_t* KPE; const float* QK; const float* ssq_kv; const float* ssq_kp; const float* kn; const float* rope; PG8_LAS float* scr;
    __device__ __forceinline__ void operator()(const f32x4 (&acc)[2][2][4][2], const Unit& u, int wr, int wc, int fr, int fq) const {
        const int h = u.pn, lane = fq * 16 + fr, rowl0 = wr * 64 + fr, row0 = u.pm * BM + rowl0, colk = wc * 32 + 8 * fq;
        float rl[2][4];
#pragma unroll
        for (int ai = 0; ai < 2; ++ai)
#pragma unroll
            for (int m = 0; m < 4; ++m) { rl[ai][m] = __builtin_amdgcn_rsqf(ssq_kv[row0 + ai * HALF + m * 16] * (1.f / KVLORA) + EPS);
                const f32x4 a0 = acc[ai][0][m][0] * rl[ai][m], a1 = acc[ai][0][m][1] * rl[ai][m];
                float s = ((a0[0] * a0[0] + a0[1] * a0[1]) + (a0[2] * a0[2] + a0[3] * a0[3])) + ((a1[0] * a1[0] + a1[1] * a1[1]) + (a1[2] * a1[2] + a1[3] * a1[3]));
                s += shx(s, 16, lane); s += shx(s, 32, lane);
                if (fq == 0) scr[(ai * HALF + rowl0 + m * 16) * 4 + wc] = s; }
        asm volatile("s_waitcnt lgkmcnt(0)" ::: "memory"); __builtin_amdgcn_s_barrier(); asm volatile("" ::: "memory");
        const f32x4 g0 = *(const f32x4*)(kn + colk), g1 = *(const f32x4*)(kn + colk + 4);
        const int dA = (wc >> 1) * 32 + (wc & 1) * 8 + 2 * fq, ff = (wc & 1) * 8 + 2 * fq;
        const f32x2 ga = *(const f32x2*)(kn + QKN + dA), gb = *(const f32x2*)(kn + QKN + dA + 16);
#pragma unroll
        for (int ai = 0; ai < 2; ++ai)
#pragma unroll
            for (int m = 0; m < 4; ++m) { const int row = row0 + ai * HALF + m * 16;
                const f32x4 p = *(const PG8_LAS f32x4*)(scr + (ai * HALF + rowl0 + m * 16) * 4);
                const float rinv = __builtin_amdgcn_rsqf((((p[0] + p[1]) + (p[2] + p[3])) + ssq_kp[row]) * (1.f / QKD) + EPS), ks = rl[ai][m] * rinv;
                bf16_t* kvp = KV + (size_t)row * (NH * 256) + h * 256 + colk;
                { const f32x4 k0 = acc[ai][0][m][0] * ks * g0, k1 = acc[ai][0][m][1] * ks * g1;
                  u32x4 w; w.x = cvt_pk_bf16(k0[0], k0[1]); w.y = cvt_pk_bf16(k0[2], k0[3]); w.z = cvt_pk_bf16(k1[0], k1[1]); w.w = cvt_pk_bf16(k1[2], k1[3]); *(u32x4*)kvp = w; }
                { const f32x4 v0 = acc[ai][1][m][0] * rl[ai][m], v1 = acc[ai][1][m][1] * rl[ai][m];
                  u32x4 w; w.x = cvt_pk_bf16(v0[0], v0[1]); w.y = cvt_pk_bf16(v0[2], v0[3]); w.z = cvt_pk_bf16(v1[0], v1[1]); w.w = cvt_pk_bf16(v1[2], v1[3]); *(u32x4*)(kvp + 128) = w; }
                const float* kp = QK + (size_t)row * NQKVA + (QLORA + KVLORA) + dA;
                const f32x2 ya = *(const f32x2*)kp * rinv * ga, yb = *(const f32x2*)(kp + 16) * rinv * gb;
                f32x2 cs = (f32x2){1.f, 1.f}, sn = (f32x2){0.f, 0.f};
                if (row < MLAT) { const int s = row & (SEQ - 1), pos = wc < 2 ? (s >> 6) : (s & 63); cs = *(const f32x2*)(rope + pos * 16 + ff); sn = *(const f32x2*)(rope + 1024 + pos * 16 + ff); }
                const f32x2 za = ya * cs - yb * sn, zb = yb * cs + ya * sn;
                bf16_t* pe = KPE + (size_t)row * (NH * QKR) + h * QKR + dA;
                *(unsigned*)pe = cvt_pk_bf16(za.x, za.y); *(unsigned*)(pe + 16) = cvt_pk_bf16(zb.x, zb.y); }
    }
};
struct EpiResidFuse {
    static constexpr bool PERM = false, AFTER_DRAIN = false, PERM64 = false;
    const float* src; float* dst; const float* gate; bf16_t* Hn; const float* gnext; const float* scn; float* ssq; PG8_LAS float* scr;
    __device__ __forceinline__ void operator()(const f32x4 (&acc)[2][2][4][2], const Unit& u, int wr, int wc, int fr, int fq) const {
        const int bidx = u.pm >> 4, row0 = u.pm * BM + wr * 64 + fr, col0 = u.pn * BM + wc * 32 + 4 * fq, lane = fq * 16 + fr;
        f32x4 gv[2][2], gs[2][2];
#pragma unroll
        for (int bj = 0; bj < 2; ++bj)
#pragma unroll
            for (int n = 0; n < 2; ++n) { const int c = col0 + bj * HALF + n * 16; gv[bj][n] = *(const f32x4*)(gate + (size_t)bidx * NMOD + c);
                gs[bj][n] = *(const f32x4*)(gnext + c) * (*(const f32x4*)(scn + (size_t)bidx * NMOD + c) + 1.0f); }
#pragma unroll
        for (int ai = 0; ai < 2; ++ai)
#pragma unroll
            for (int m = 0; m < 4; ++m) { const int row = row0 + ai * HALF + m * 16; const size_t off = (size_t)row * DM + col0; float ss = 0.f;
#pragma unroll
                for (int bj = 0; bj < 2; ++bj)
#pragma unroll
                    for (int n = 0; n < 2; ++n) { const f32x4 x = *(const f32x4*)(src + off + bj * HALF + n * 16) + gv[bj][n] * acc[ai][bj][m][n];
                        *(f32x4*)(dst + off + bj * HALF + n * 16) = x; ss += (x[0] * x[0] + x[1] * x[1]) + (x[2] * x[2] + x[3] * x[3]);
                        const f32x4 hh = x * gs[bj][n]; u32x2 w; w.x = cvt_pk_bf16(hh[0], hh[1]); w.y = cvt_pk_bf16(hh[2], hh[3]); *(u32x2*)(Hn + off + bj * HALF + n * 16) = w; }
                ss += shx(ss, 16, lane); ss += shx(ss, 32, lane);
                if (fq == 0) scr[(ai * HALF + wr * 64 + m * 16 + fr) * 4 + wc] = ss; }
        asm volatile("s_waitcnt lgkmcnt(0)" ::: "memory"); __builtin_amdgcn_s_barrier(); asm volatile("" ::: "memory");
        if (lane < 32) { const int rl = 32 * (wr * 4 + wc) + lane; const f32x4 p = *(const PG8_LAS f32x4*)(scr + rl * 4); atomicAdd(ssq + u.pm * BM + rl, (p[0] + p[1]) + (p[2] + p[3])); }
    }
};
struct EpiResid {
    static constexpr bool PERM = false, AFTER_DRAIN = false, PERM64 = false;
    const float* srcLat; const float* srcCtx; float* dstLat; float* dstCtx; const float* gate;
    __device__ __forceinline__ void operator()(const f32x4 (&acc)[2][2][4][2], const Unit& u, int wr, int wc, int fr, int fq) const {
        const bool lat = u.pm < MLAT / BM;
        const int rbase = lat ? u.pm * BM : u.pm * BM - MLAT, bidx = lat ? (u.pm >> 4) : 4;
        const float* src = lat ? srcLat : srcCtx; float* dst = lat ? dstLat : dstCtx;
        const int row0 = rbase + wr * 64 + fr, col0 = u.pn * BM + wc * 32 + 4 * fq;
        const float* gp = gate + (size_t)bidx * NMOD + col0;
        f32x4 gv[2][2];
#pragma unroll
        for (int bj = 0; bj < 2; ++bj)
#pragma unroll
            for (int n = 0; n < 2; ++n) gv[bj][n] = *(const f32x4*)(gp + bj * HALF + n * 16);
#pragma unroll
        for (int ai = 0; ai < 2; ++ai)
#pragma unroll
            for (int m = 0; m < 4; ++m) { const size_t off = (size_t)(row0 + ai * HALF + m * 16) * DM + col0;
#pragma unroll
                for (int bj = 0; bj < 2; ++bj)
#pragma unroll
                    for (int n = 0; n < 2; ++n) { const f32x4 s = *(const f32x4*)(src + off + bj * HALF + n * 16);
                        *(f32x4*)(dst + off + bj * HALF + n * 16) = s + gv[bj][n] * acc[ai][bj][m][n]; } }
    }
};
struct EpiSlab {
    static constexpr bool PERM = false, AFTER_DRAIN = false, PERM64 = false;
    float* slab; const float* gate;
    __device__ __forceinline__ void operator()(const f32x4 (&acc)[2][2][4][2], const Unit& u, int wr, int wc, int fr, int fq) const {
        const int row0 = u.pk * MCTX + (u.pm * BM - MLAT) + wr * 64 + fr, col0 = u.pn * BM + wc * 32 + 4 * fq;
        const float* gp = gate + (size_t)4 * NMOD + col0;
        f32x4 gv[2][2];
#pragma unroll
        for (int bj = 0; bj < 2; ++bj)
#pragma unroll
            for (int n = 0; n < 2; ++n) gv[bj][n] = *(const f32x4*)(gp + bj * HALF + n * 16);
#pragma unroll
        for (int ai = 0; ai < 2; ++ai)
#pragma unroll
            for (int m = 0; m < 4; ++m) { float* rowp = slab + (size_t)(row0 + ai * HALF + m * 16) * DM + col0;
#pragma unroll
                for (int bj = 0; bj < 2; ++bj)
#pragma unroll
                    for (int n = 0; n < 2; ++n) *(f32x4*)(rowp + bj * HALF + n * 16) = gv[bj][n] * acc[ai][bj][m][n]; }
    }
};
struct EpiGeluT {
    static constexpr bool PERM = true, AFTER_DRAIN = false, PERM64 = false;
    bf16_t* O; int ldc; float* S1; float* S2; const float* ssq; const float* bias; int ldbias;
    __device__ __forceinline__ void operator()(const f32x4 (&acc)[2][2][4][2], const Unit& u, int wr, int wc, int fr, int fq) const {
        const int row0 = u.pm * BM + wr * 64 + fr, col0 = u.pn * BM + wc * 32 + 8 * fq;
        const bool fused = ssq != nullptr && u.pn < MLAT / BM;
        f32x4 rv[2][2];
#pragma unroll
        for (int bj = 0; bj < 2; ++bj)
#pragma unroll
            for (int n = 0; n < 2; ++n) { if (fused) { const f32x4 q = *(const f32x4*)(ssq + col0 + bj * HALF + 4 * n);
#pragma unroll
                    for (int e = 0; e < 4; ++e) rv[bj][n][e] = __builtin_amdgcn_rsqf(q[e] * (1.f / DM) + EPS); } else rv[bj][n] = (f32x4){1.f, 1.f, 1.f, 1.f}; }
        f32x4 s1[2][2], s2[2][2];
#pragma unroll
        for (int bj = 0; bj < 2; ++bj)
#pragma unroll
            for (int n = 0; n < 2; ++n) { s1[bj][n] = (f32x4){0.f, 0.f, 0.f, 0.f}; s2[bj][n] = (f32x4){0.f, 0.f, 0.f, 0.f}; }
#pragma unroll
        for (int ai = 0; ai < 2; ++ai)
#pragma unroll
            for (int m = 0; m < 4; ++m) { bf16_t* rowp = O + (size_t)(row0 + ai * HALF + m * 16) * ldc + col0;
                const float bb = fused ? bias[(size_t)(u.pn >> 4) * ldbias + row0 + ai * HALF + m * 16] : 0.f;
#pragma unroll
                for (int bj = 0; bj < 2; ++bj) { const f32x4 v0 = act4(acc[ai][bj][m][0] * rv[bj][0] + bb, 1), v1 = act4(acc[ai][bj][m][1] * rv[bj][1] + bb, 1);
                    s1[bj][0] += v0; s1[bj][1] += v1; s2[bj][0] += v0 * v0; s2[bj][1] += v1 * v1;
                    u32x4 w; w.x = cvt_pk_bf16(v0[0], v0[1]); w.y = cvt_pk_bf16(v0[2], v0[3]); w.z = cvt_pk_bf16(v1[0], v1[1]); w.w = cvt_pk_bf16(v1[2], v1[3]);
                    *(u32x4*)(rowp + bj * HALF) = w; } }
        float my1 = 0.f, my2 = 0.f;
#pragma unroll
        for (int bj = 0; bj < 2; ++bj)
#pragma unroll
            for (int n = 0; n < 2; ++n)
#pragma unroll
                for (int e = 0; e < 4; ++e) { const float a = row16_sum(s1[bj][n][e]), b = row16_sum(s2[bj][n][e]);
                    const bool mine = fr == bj * 8 + n * 4 + e; my1 = mine ? a : my1; my2 = mine ? b : my2; }
        { const int col = col0 + (fr >> 3) * HALF + ((fr >> 2) & 1) * 4 + (fr & 3); atomicAdd(S1 + col, my1); atomicAdd(S2 + col, my2); }
    }
};
struct EpiGate {
    static constexpr bool PERM = true, AFTER_DRAIN = false, PERM64 = false;
    bf16_t* U; int ldc; const float* bs;
    __device__ __forceinline__ void operator()(const f32x4 (&acc)[2][2][4][2], const Unit& u, int wr, int wc, int fr, int fq) const {
        const int row0 = u.pm * BM + wr * 64 + fr, col0 = u.pn * BM + wc * 32 + 8 * fq;
#pragma unroll
        for (int ai = 0; ai < 2; ++ai)
#pragma unroll
            for (int m = 0; m < 4; ++m) { const int row = row0 + ai * HALF + m * 16; const float bias = bs[u.pn * 128 + (row & 127)];
                bf16_t* rowp = U + (size_t)row * ldc + col0;
#pragma unroll
                for (int bj = 0; bj < 2; ++bj) { const u32x4 uu = *(const u32x4*)(rowp + bj * HALF);
                    const f32x4 a0 = acc[ai][bj][m][0] + bias, a1 = acc[ai][bj][m][1] + bias;
                    u32x4 w; w.x = cvt_pk_bf16(bf_lo(uu.x) * a0[0], bf_hi(uu.x) * a0[1]); w.y = cvt_pk_bf16(bf_lo(uu.y) * a0[2], bf_hi(uu.y) * a0[3]);
                    w.z = cvt_pk_bf16(bf_lo(uu.z) * a1[0], bf_hi(uu.z) * a1[1]); w.w = cvt_pk_bf16(bf_lo(uu.w) * a1[2], bf_hi(uu.w) * a1[3]);
                    *(u32x4*)(rowp + bj * HALF) = w; } }
    }
};

template <class Epi, class Sched, bool ALIGN_EPI = false, bool SP2 = false>
__device__ __forceinline__ void gemm_phase(PG8_LAS unsigned char* lds, const Gemm g, const Sched& S, const Epi& E) {
    int tid_ = threadIdx.x; asm volatile("" : "+v"(tid_));
    const int tid = tid_, wid = __builtin_amdgcn_readfirstlane(tid >> 6), lane = tid & 63, wr = wid >> 2, wc = wid & 3, fr = lane & 15, fq = lane >> 4;
    const int K = g.K, nt = K / BK;
    unsigned voffA[2], voffB[2];
#pragma unroll
    for (int i = 0; i < 2; ++i) { int R, C; stage_rc(tid * 16 + i * 8192, R, C); const int Rb = Epi::PERM ? (Epi::PERM64 ? (64 * (R >> 5) + perm32(R & 31)) : ((R & ~31) + perm32(R & 31))) : R;
        voffA[i] = (unsigned)(R * g.lda + C) * 2u; voffB[i] = (unsigned)(Rb * g.ldb + C) * 2u; }
    const size_t kstep = (size_t)(BK * 2);
    const size_t hstepA = (size_t)HALF * g.lda * 2, hstepB = (size_t)(Epi::PERM64 ? 32 : HALF) * g.ldb * 2;
    const unsigned ldsw = (unsigned)wid * 1024u;
    const int aoff = lds_byte(wr * 64 + fr, fq * 8), boff = lds_byte(wc * 32 + fr, fq * 8);
#define PG8_SA(b, h) (((b) * 2 + (h)) * HTB)
#define PG8_SB(b, h) ((4 + (b) * 2 + (h)) * HTB)
#define PG8_STAGE(bufoff, gbase, voff) do { _Pragma("unroll") for (int _i = 0; _i < 2; ++_i) \
        __builtin_amdgcn_global_load_lds((const unsigned*)((const char*)(gbase) + (voff)[_i]), (PG8_LAS unsigned*)(lds + (bufoff) + ldsw + _i * 8192), 16, 0, 0); } while (0)
#define PG8_LDA(dst, b, h) do { _Pragma("unroll") for (int m = 0; m < 4; ++m) _Pragma("unroll") for (int k = 0; k < 2; ++k) dst[m][k] = *(const PG8_LAS bf16x8*)(lds + PG8_SA(b, h) + aoff + m * 2048 + k * 1024); } while (0)
#define PG8_LDB(dst, b, h) do { _Pragma("unroll") for (int n = 0; n < 2; ++n) _Pragma("unroll") for (int k = 0; k < 2; ++k) dst[n][k] = *(const PG8_LAS bf16x8*)(lds + PG8_SB(b, h) + boff + n * 2048 + k * 1024); } while (0)
#define PG8_MMA(ai, bj, At, Bt) do { __builtin_amdgcn_s_setprio(1); _Pragma("unroll") for (int m = 0; m < 4; ++m) _Pragma("unroll") for (int n = 0; n < 2; ++n) _Pragma("unroll") for (int k = 0; k < 2; ++k) \
        acc[ai][bj][m][n] = __builtin_amdgcn_mfma_f32_16x16x32_bf16(Bt[n][k], At[m][k], acc[ai][bj][m][n], 0, 0, 0); __builtin_amdgcn_s_setprio(0); } while (0)
#define PG8_WAIT_V(n) asm volatile("s_waitcnt vmcnt(" #n ")" ::: "memory")
#define PG8_WAIT_L(n) asm volatile("s_waitcnt lgkmcnt(" #n ")" ::: "memory")
#define PG8_BAR __builtin_amdgcn_s_barrier()
#define PG8_SCHED __builtin_amdgcn_sched_barrier(0)
    Unit cur, nxt; int ui = 0;
    if (!S.next(0, cur)) return;
    f32x4 acc[2][2][4][2];
#pragma unroll
    for (int a = 0; a < 2; ++a)
#pragma unroll
        for (int b = 0; b < 2; ++b)
#pragma unroll
            for (int m = 0; m < 4; ++m)
#pragma unroll
                for (int n = 0; n < 2; ++n) acc[a][b][m][n] = (f32x4){0.f, 0.f, 0.f, 0.f};
    bf16x8 At[4][2], B0[2][2], B1[2][2];
    const char* cA = g.a_of(cur); const char* cB = g.b_of(cur);
    S.a_ready(cur);
    if constexpr (SP2) {
        PG8_STAGE(PG8_SB(0, 0), cB, voffB); PG8_STAGE(PG8_SB(0, 1), cB + hstepB, voffB); PG8_STAGE(PG8_SA(0, 0), cA, voffA); PG8_STAGE(PG8_SA(0, 1), cA + hstepA, voffA);
        if (wr == 1) PG8_BAR;
        PG8_WAIT_V(2); PG8_BAR;
        PG8_STAGE(PG8_SB(1, 0), cB + kstep, voffB); PG8_STAGE(PG8_SA(1, 0), cA + kstep, voffA); PG8_STAGE(PG8_SB(1, 1), cB + hstepB + kstep, voffB);
        PG8_WAIT_V(6); PG8_BAR;
    } else {
        PG8_STAGE(PG8_SB(0, 0), cB, voffB); PG8_STAGE(PG8_SA(0, 0), cA, voffA); PG8_STAGE(PG8_SB(0, 1), cB + hstepB, voffB); PG8_STAGE(PG8_SA(0, 1), cA + hstepA, voffA);
        if (wr == 1) PG8_BAR;
        PG8_WAIT_V(4); PG8_BAR;
        PG8_STAGE(PG8_SB(1, 0), cB + kstep, voffB); PG8_STAGE(PG8_SA(1, 0), cA + kstep, voffA); PG8_STAGE(PG8_SB(1, 1), cB + hstepB + kstep, voffB);
        PG8_WAIT_V(6); PG8_BAR;
    }
    for (;;) {
        const bool has_next = S.next(ui + 1, nxt);
        const char* nA = has_next ? g.a_of(nxt) : cA; const char* nB = has_next ? g.b_of(nxt) : cB;
        for (int t = 0; t < nt; t += 2) {
            const bool last = (t == nt - 2);
            const char* a1 = cA + (size_t)(t + 1) * kstep;
            const char* a2 = last ? nA : cA + (size_t)(t + 2) * kstep; const char* b2 = last ? nB : cB + (size_t)(t + 2) * kstep;
            const char* a3 = a2 + kstep; const char* b3 = b2 + kstep;
            if (last && has_next) S.a_ready(nxt);
            if constexpr (SP2) {
            PG8_LDB(B0, 0, 0); PG8_LDB(B1, 0, 1); PG8_SCHED; PG8_LDA(At, 0, 0); PG8_STAGE(PG8_SA(1, 1), a1 + hstepA, voffA);
            PG8_WAIT_V(8); PG8_WAIT_L(0); PG8_BAR; PG8_MMA(0, 0, At, B0); PG8_MMA(0, 1, At, B1); PG8_BAR; PG8_SCHED;
            PG8_LDA(At, 0, 1); PG8_STAGE(PG8_SB(0, 0), b2, voffB); PG8_STAGE(PG8_SB(0, 1), b2 + hstepB, voffB); PG8_STAGE(PG8_SA(0, 0), a2, voffA);
            PG8_WAIT_V(8); PG8_WAIT_L(0); PG8_BAR; PG8_MMA(1, 0, At, B0); PG8_MMA(1, 1, At, B1); PG8_BAR; PG8_SCHED;
            PG8_LDB(B0, 1, 0); PG8_LDB(B1, 1, 1); PG8_SCHED; PG8_LDA(At, 1, 0); PG8_STAGE(PG8_SA(0, 1), a2 + hstepA, voffA);
            PG8_WAIT_V(8); PG8_WAIT_L(0); PG8_BAR; PG8_MMA(0, 0, At, B0); PG8_MMA(0, 1, At, B1); PG8_BAR; PG8_SCHED;
            PG8_LDA(At, 1, 1); PG8_STAGE(PG8_SB(1, 0), b3, voffB); PG8_STAGE(PG8_SB(1, 1), b3 + hstepB, voffB); PG8_STAGE(PG8_SA(1, 0), a3, voffA);
            PG8_WAIT_V(8); PG8_WAIT_L(0); PG8_BAR; PG8_MMA(1, 0, At, B0); PG8_MMA(1, 1, At, B1); PG8_BAR; PG8_SCHED;
            } else {
            PG8_LDB(B0, 0, 0); PG8_SCHED; PG8_LDA(At, 0, 0); PG8_STAGE(PG8_SA(1, 1), a1 + hstepA, voffA);
            PG8_WAIT_L(8); PG8_BAR; PG8_WAIT_L(0); PG8_MMA(0, 0, At, B0); PG8_BAR; PG8_SCHED;
            PG8_LDB(B1, 0, 1); PG8_STAGE(PG8_SB(0, 0), b2, voffB);
            PG8_BAR; PG8_WAIT_L(0); PG8_MMA(0, 1, At, B1); PG8_BAR;
            PG8_LDA(At, 0, 1); PG8_STAGE(PG8_SA(0, 0), a2, voffA);
            PG8_BAR; PG8_WAIT_L(0); PG8_MMA(1, 0, At, B0); PG8_BAR; PG8_SCHED;
            PG8_STAGE(PG8_SB(0, 1), b2 + hstepB, voffB);
            PG8_WAIT_V(6); PG8_BAR; PG8_MMA(1, 1, At, B1); PG8_BAR;
            PG8_LDB(B0, 1, 0); PG8_SCHED; PG8_LDA(At, 1, 0); PG8_STAGE(PG8_SA(0, 1), a2 + hstepA, voffA);
            PG8_WAIT_L(8); PG8_BAR; PG8_WAIT_L(0); PG8_MMA(0, 0, At, B0); PG8_BAR; PG8_SCHED;
            PG8_LDB(B1, 1, 1); PG8_STAGE(PG8_SB(1, 0), b3, voffB);
            PG8_BAR; PG8_WAIT_L(0); PG8_MMA(0, 1, At, B1); PG8_BAR;
            PG8_LDA(At, 1, 1); PG8_STAGE(PG8_SA(1, 0), a3, voffA);
            PG8_BAR; PG8_WAIT_L(0); PG8_MMA(1, 0, At, B0); PG8_BAR; PG8_SCHED;
            PG8_STAGE(PG8_SB(1, 1), b3 + hstepB, voffB);
            PG8_WAIT_V(6); PG8_BAR; PG8_MMA(1, 1, At, B1); PG8_BAR;
            }
        }
        if constexpr (ALIGN_EPI) { if (wr == 0) PG8_BAR; }
        if constexpr (!Epi::AFTER_DRAIN) { E(acc, cur, wr, wc, fr, fq); S.done(cur); }
        if (!has_next) break;
#pragma unroll
        for (int a = 0; a < 2; ++a)
#pragma unroll
            for (int b = 0; b < 2; ++b)
#pragma unroll
                for (int m = 0; m < 4; ++m)
#pragma unroll
                    for (int n = 0; n < 2; ++n) acc[a][b][m][n] = (f32x4){0.f, 0.f, 0.f, 0.f};
        cur = nxt; cA = nA; cB = nB; ++ui;
        if constexpr (ALIGN_EPI) { if (wr == 1) PG8_BAR; }
    }
    PG8_WAIT_V(0);
    if constexpr (!ALIGN_EPI) { if (wr == 0) PG8_BAR; }
    PG8_BAR;
    if constexpr (Epi::AFTER_DRAIN) { E.fused(acc, cur, wr, wc, fr, fq, lds, wid, lane); S.done(cur); }
#undef PG8_SA
#undef PG8_SB
#undef PG8_STAGE
#undef PG8_LDA
#undef PG8_LDB
#undef PG8_MMA
#undef PG8_WAIT_V
#undef PG8_WAIT_L
#undef PG8_BAR
#undef PG8_SCHED
}
}

__device__ __forceinline__ void unpack8(const u32x4 w, float* f) { f[0] = bf_lo(w.x); f[1] = bf_hi(w.x); f[2] = bf_lo(w.y); f[3] = bf_hi(w.y); f[4] = bf_lo(w.z); f[5] = bf_hi(w.z); f[6] = bf_lo(w.w); f[7] = bf_hi(w.w); }
__device__ __forceinline__ u32x4 pack8(const float* f) { u32x4 w; w.x = cvt_pk_bf16(f[0], f[1]); w.y = cvt_pk_bf16(f[2], f[3]); w.z = cvt_pk_bf16(f[4], f[5]); w.w = cvt_pk_bf16(f[6], f[7]); return w; }
namespace att {
using f32x16 = __attribute__((ext_vector_type(16))) float;
using s16x4  = __attribute__((ext_vector_type(4))) short;
constexpr int NW = 8, QBLK = 32, KVBLK = 64;
constexpr float SCALE = 0.072168783648703220f;
constexpr float THR = 8.f;
constexpr int LDQ = NH * QKD, LDKV = NH * 256, LDKP = NH * QKR, LDO = NH * VD;
constexpr int SHM_V = KVBLK * 128 * 2, SHM_KN = KVBLK * 128 * 2, SHM_KP = KVBLK * 64 * 2;
constexpr int OFF_V = 0, OFF_KN = 2 * SHM_V, OFF_KP = OFF_KN + 2 * SHM_KN, OFF_WS = OFF_KP + 2 * SHM_KP, SHM_ATTN = OFF_WS + NW * 64 * 4;
#define KSWZ(row, colB) ((row) * 256 + ((colB) ^ (((row) & 15) << 4)))
#define KPSWZ(row, colB) ((row) * 128 + ((colB) ^ ((((row) >> 1) & 7) << 4)))
#define SBAR() __builtin_amdgcn_sched_barrier(0)
__device__ __forceinline__ int crow(int r, int hi) { return (r & 3) + 8 * (r >> 2) + 4 * hi; }
__device__ __forceinline__ unsigned cvtpk(float lo, float hi) { unsigned r; asm volatile("v_cvt_pk_bf16_f32 %0, %1, %2" : "=v"(r) : "v"(lo), "v"(hi)); return r; }
__device__ __forceinline__ bf16x8 ld8(const bf16_t* p) { return *reinterpret_cast<const bf16x8*>(p); }

__device__ __forceinline__ void partialSM(f32x16& p0, f32x16& p1, float& m_reg, float& mn, float& alpha) {
  constexpr float C = SCALE * 1.4426950408889634f;
  float pmax = p0[0]; for (int r = 1; r < 16; ++r) pmax = fmaxf(pmax, p0[r]); for (int r = 0; r < 16; ++r) pmax = fmaxf(pmax, p1[r]);
  { auto rr = __builtin_amdgcn_permlane32_swap(__float_as_uint(pmax), __float_as_uint(pmax), false, false);
    pmax = fmaxf(__uint_as_float(rr[0]), __uint_as_float(rr[1])); }
  if (__builtin_expect(__all(pmax - m_reg <= THR / SCALE), 1)) { mn = m_reg; alpha = 1.f; }
  else { mn = fmaxf(m_reg, pmax); alpha = __builtin_amdgcn_exp2f((m_reg - mn) * C); m_reg = mn; }
  float mnC = -mn * C;
  for (int r = 0; r < 16; ++r) p0[r] = fmaf(p0[r], C, mnC); for (int r = 0; r < 16; ++r) p1[r] = fmaf(p1[r], C, mnC);
  for (int r = 0; r < 16; ++r) p0[r] = __builtin_amdgcn_exp2f(p0[r]);
}
__device__ __forceinline__ void finishSM(f32x16& p0, f32x16& p1, float alpha, float& l_reg, bf16x8& pa0, bf16x8& pa1, bf16x8& pa2, bf16x8& pa3) {
  for (int r = 0; r < 16; ++r) p1[r] = __builtin_amdgcn_exp2f(p1[r]);
  float ps = 0; for (int r = 0; r < 16; ++r) ps += p0[r]; for (int r = 0; r < 16; ++r) ps += p1[r];
  { auto rr = __builtin_amdgcn_permlane32_swap(__float_as_uint(ps), __float_as_uint(ps), false, false);
    ps = __uint_as_float(rr[0]) + __uint_as_float(rr[1]); }
  l_reg = l_reg * alpha + ps;
#define PK4(P, BASE, OUT) do { unsigned a0 = cvtpk(P[BASE + 0], P[BASE + 1]), a1 = cvtpk(P[BASE + 2], P[BASE + 3]);   \
    unsigned b0 = cvtpk(P[BASE + 4], P[BASE + 5]), b1 = cvtpk(P[BASE + 6], P[BASE + 7]);                              \
    auto r0 = __builtin_amdgcn_permlane32_swap(a0, b0, false, false); auto r1 = __builtin_amdgcn_permlane32_swap(a1, b1, false, false); \
    u32x4 w = {r0[0], r1[0], r0[1], r1[1]}; OUT = *reinterpret_cast<bf16x8*>(&w); } while (0)
  PK4(p0, 0, pa0); PK4(p0, 8, pa1); PK4(p1, 0, pa2); PK4(p1, 8, pa3);
#undef PK4
}
__device__ __forceinline__ void qkt(f32x16& p0, f32x16& p1, const char* Kn, const char* Kp, const bf16x8* qr, int r32, int hi) {
  p0 = f32x16{}; p1 = f32x16{};
#pragma unroll
  for (int d0 = 0; d0 < 8; ++d0) { int cb = (d0 * 16 + hi * 8) * 2;
    bf16x8 b0 = *reinterpret_cast<const bf16x8*>(Kn + KSWZ(r32, cb));
    bf16x8 b1 = *reinterpret_cast<const bf16x8*>(Kn + KSWZ(32 + r32, cb));
    p0 = __builtin_amdgcn_mfma_f32_32x32x16_bf16(b0, qr[d0], p0, 0, 0, 0);
    p1 = __builtin_amdgcn_mfma_f32_32x32x16_bf16(b1, qr[d0], p1, 0, 0, 0); }
#pragma unroll
  for (int d1 = 0; d1 < 4; ++d1) { int cb = (d1 * 16 + hi * 8) * 2;
    bf16x8 b0 = *reinterpret_cast<const bf16x8*>(Kp + KPSWZ(r32, cb));
    bf16x8 b1 = *reinterpret_cast<const bf16x8*>(Kp + KPSWZ(32 + r32, cb));
    p0 = __builtin_amdgcn_mfma_f32_32x32x16_bf16(b0, qr[8 + d1], p0, 0, 0, 0);
    p1 = __builtin_amdgcn_mfma_f32_32x32x16_bf16(b1, qr[8 + d1], p1, 0, 0, 0); }
}
__device__ __forceinline__ int v_st(int k, int c) { const int kk = (k & ~0xC) | ((k & 4) << 1) | ((k & 8) >> 1); return ((kk >> 3) * 4 + (c >> 5)) * 512 + ((kk & 7) * 32 + (c & 31)) * 2; }
__device__ __forceinline__ int v_rd_base(int lane) { return ((lane & 3) << 3) | (((lane >> 2) & 3) << 6) | (((lane >> 4) & 1) << 5) | (((lane >> 5) & 1) << 8); }
constexpr int v_rd_off(int d0, int ks, int half) { return d0 * 512 + ks * 4096 + half * 2048; }
template <int OFF> __device__ __forceinline__ s16x4 tr_read(int vb) {
  s16x4 r; asm volatile("ds_read_b64_tr_b16 %0, %1 offset:%2" : "=&v"(r) : "v"(vb), "i"(OFF) : "memory"); return r;
}
template <int D0> __device__ __forceinline__ void pv_one(f32x16& od, int vb, bf16x8 pa0, bf16x8 pa1, bf16x8 pa2, bf16x8 pa3) {
  const s16x4 l0 = tr_read<v_rd_off(D0, 0, 0)>(vb), h0 = tr_read<v_rd_off(D0, 0, 1)>(vb), l1 = tr_read<v_rd_off(D0, 1, 0)>(vb), h1 = tr_read<v_rd_off(D0, 1, 1)>(vb);
  const s16x4 l2 = tr_read<v_rd_off(D0, 2, 0)>(vb), h2 = tr_read<v_rd_off(D0, 2, 1)>(vb), l3 = tr_read<v_rd_off(D0, 3, 0)>(vb), h3 = tr_read<v_rd_off(D0, 3, 1)>(vb);
  asm volatile("s_waitcnt lgkmcnt(0)" ::: "memory"); SBAR();
#define PK(L, H) (bf16x8){L[0], L[1], L[2], L[3], H[0], H[1], H[2], H[3]}
  od = __builtin_amdgcn_mfma_f32_32x32x16_bf16(pa0, PK(l0, h0), od, 0, 0, 0);
  od = __builtin_amdgcn_mfma_f32_32x32x16_bf16(pa1, PK(l1, h1), od, 0, 0, 0);
  od = __builtin_amdgcn_mfma_f32_32x32x16_bf16(pa2, PK(l2, h2), od, 0, 0, 0);
  od = __builtin_amdgcn_mfma_f32_32x32x16_bf16(pa3, PK(l3, h3), od, 0, 0, 0);
#undef PK
}
__device__ __forceinline__ void pv_d0(f32x16* o, int vb, bf16x8 pa0, bf16x8 pa1, bf16x8 pa2, bf16x8 pa3) {
  pv_one<0>(o[0], vb, pa0, pa1, pa2, pa3); pv_one<1>(o[1], vb, pa0, pa1, pa2, pa3); pv_one<2>(o[2], vb, pa0, pa1, pa2, pa3); pv_one<3>(o[3], vb, pa0, pa1, pa2, pa3);
}

__device__ __forceinline__ void attn_unit(const bf16_t* __restrict__ Qb, const bf16_t* __restrict__ KV, const bf16_t* __restrict__ KP, bf16_t* __restrict__ Ob,
                                          int h, int qrow0, int ctx0, int lat0, int NT, char* lds, const float* __restrict__ qn, const float* __restrict__ rope, bool do_rope) {
  int tid_ = threadIdx.x; asm volatile("" : "+v"(tid_));
  const int tid = tid_, wid = tid >> 6, lane = tid & 63, r32 = lane & 31, hi = lane >> 5;
  char* V_lds = lds + OFF_V; char* KN_lds = lds + OFF_KN; char* KP_lds = lds + OFF_KP;
  float* ws = (float*)(lds + OFF_WS) + wid * 64; float* li_l = ws; float* al_l = ws + 32;
  float m_reg = -1e30f, l_reg = 0; f32x16 o[4] = {}; bf16x8 qr[12];
  const bf16_t* Qw = Qb + (size_t)(qrow0 + wid * QBLK + r32) * LDQ + h * QKD + hi * 8;
#pragma unroll
  for (int d0 = 0; d0 < 12; ++d0) qr[d0] = ld8(Qw + d0 * 16);
  {
    float qf[12][8]; float ss = 0.f;
#pragma unroll
    for (int d0 = 0; d0 < 12; ++d0) { const u32x4 w = *reinterpret_cast<const u32x4*>(&qr[d0]); unpack8(w, qf[d0]);
#pragma unroll
      for (int jj = 0; jj < 8; ++jj) ss += qf[d0][jj] * qf[d0][jj]; }
    { auto rr = __builtin_amdgcn_permlane32_swap(__float_as_uint(ss), __float_as_uint(ss), false, false); ss = __uint_as_float(rr[0]) + __uint_as_float(rr[1]); }
    const float rinv = 1.0f / sqrtf(ss * (1.f / QKD) + EPS);
#pragma unroll
    for (int d0 = 0; d0 < 12; ++d0) { const f32x4 g0 = *(const f32x4*)(qn + d0 * 16 + hi * 8), g1 = *(const f32x4*)(qn + d0 * 16 + hi * 8 + 4);
#pragma unroll
      for (int jj = 0; jj < 8; ++jj) qf[d0][jj] *= rinv * (jj < 4 ? g0[jj & 3] : g1[jj & 3]); }
    if (do_rope) { const int s = (qrow0 + wid * QBLK + r32) & (SEQ - 1), pr_ = s >> 6, pc_ = s & 63;
#pragma unroll
      for (int ax = 0; ax < 2; ++ax) { const float* cp = rope + (ax ? pc_ : pr_) * 16 + hi * 8; const f32x4 c0 = *(const f32x4*)cp, c1 = *(const f32x4*)(cp + 4), s0 = *(const f32x4*)(cp + 1024), s1 = *(const f32x4*)(cp + 1028);
#pragma unroll
        for (int jj = 0; jj < 8; ++jj) { const float c = jj < 4 ? c0[jj & 3] : c1[jj & 3], sn = jj < 4 ? s0[jj & 3] : s1[jj & 3], a = qf[8 + 2 * ax][jj], b = qf[9 + 2 * ax][jj];
          qf[8 + 2 * ax][jj] = a * c - b * sn; qf[9 + 2 * ax][jj] = b * c + a * sn; } } }
#pragma unroll
    for (int d0 = 0; d0 < 12; ++d0) { const u32x4 w = pack8(qf[d0]); qr[d0] = *reinterpret_cast<const bf16x8*>(&w); }
  }
  const int sr = tid >> 4, sc = (tid & 15) * 8, vst0 = v_st(sr, sc), vst1 = v_st(32 + sr, sc);
  const int pr = tid >> 3, pc = (tid & 7) * 8;
  const int vb0 = (int)(uintptr_t)V_lds + v_rd_base(lane);
  bf16x8 vs0, vs1, ks0, ks1, kp0;
  const bf16_t* KVh = KV + h * 256; const bf16_t* KPh = KP + h * QKR;
#define TROW(j) ((j) < 4 ? ctx0 + (j) * KVBLK : lat0 + ((j) - 4) * KVBLK)
#define SLOAD(j) do { const int r0_ = TROW(j); const bf16_t* a_ = KVh + (size_t)(r0_ + sr) * LDKV + sc; const bf16_t* b_ = KVh + (size_t)(r0_ + 32 + sr) * LDKV + sc; \
    vs0 = ld8(a_ + 128); vs1 = ld8(b_ + 128); ks0 = ld8(a_); ks1 = ld8(b_); kp0 = ld8(KPh + (size_t)(r0_ + pr) * LDKP + pc); } while (0)
#define SWRITE(b) do { *(bf16x8*)(V_lds + (b) * SHM_V + vst0) = vs0; *(bf16x8*)(V_lds + (b) * SHM_V + vst1) = vs1; const int kc = sc * 2; \
    *(bf16x8*)(KN_lds + (b) * SHM_KN + KSWZ(sr, kc)) = ks0; *(bf16x8*)(KN_lds + (b) * SHM_KN + KSWZ(32 + sr, kc)) = ks1; \
    *(bf16x8*)(KP_lds + (b) * SHM_KP + KPSWZ(pr, pc * 2)) = kp0; } while (0)
#define SWAIT() asm volatile("s_waitcnt vmcnt(0)" ::: "memory")
#define RESC(a) do { if (__any((a) < 1.f)) { if (hi == 0) al_l[r32] = (a); asm volatile("s_waitcnt lgkmcnt(0)" ::: "memory"); \
    for (int d = 0; d < 4; ++d) for (int r = 0; r < 16; ++r) o[d][r] *= al_l[crow(r, hi)]; } } while (0)
  f32x16 pA0, pA1, pB0, pB1; float mnA, mnB, alA, alB; bf16x8 pa0, pa1, pa2, pa3;
  SLOAD(0); SWAIT(); SWRITE(0); __syncthreads();
  qkt(pA0, pA1, KN_lds, KP_lds, qr, r32, hi); partialSM(pA0, pA1, m_reg, mnA, alA);
  SLOAD(1);
  SWAIT(); SWRITE(1); __syncthreads();
  for (int j = 1; j + 1 < NT; j += 2) {
    SBAR(); qkt(pB0, pB1, KN_lds + SHM_KN, KP_lds + SHM_KP, qr, r32, hi);
    finishSM(pA0, pA1, alA, l_reg, pa0, pa1, pa2, pa3); SBAR();
    SLOAD(j + 1); SBAR();
    pv_d0(o, vb0, pa0, pa1, pa2, pa3); partialSM(pB0, pB1, m_reg, mnB, alB);
    __syncthreads(); SWAIT(); SWRITE(0);
    RESC(alB); __syncthreads();
    SBAR(); qkt(pA0, pA1, KN_lds, KP_lds, qr, r32, hi);
    finishSM(pB0, pB1, alB, l_reg, pa0, pa1, pa2, pa3); SBAR();
    SLOAD(j + 2); SBAR();
    pv_d0(o, vb0 + SHM_V, pa0, pa1, pa2, pa3); partialSM(pA0, pA1, m_reg, mnA, alA);
    __syncthreads(); SWAIT(); SWRITE(1);
    RESC(alA); __syncthreads();
  }
  SBAR(); qkt(pB0, pB1, KN_lds + SHM_KN, KP_lds + SHM_KP, qr, r32, hi);
  finishSM(pA0, pA1, alA, l_reg, pa0, pa1, pa2, pa3); SBAR();
  pv_d0(o, vb0, pa0, pa1, pa2, pa3); partialSM(pB0, pB1, m_reg, mnB, alB);
  __syncthreads(); RESC(alB);
  finishSM(pB0, pB1, alB, l_reg, pa0, pa1, pa2, pa3); SBAR();
  pv_d0(o, vb0 + SHM_V, pa0, pa1, pa2, pa3);
  if (hi == 0) li_l[r32] = l_reg; asm volatile("s_waitcnt lgkmcnt(0)" ::: "memory");
  float rli[16];
#pragma unroll
  for (int r = 0; r < 16; ++r) rli[r] = __builtin_amdgcn_rcpf(li_l[crow(r, hi)]);
  bf16_t* Ow = Ob + (size_t)(qrow0 + wid * QBLK) * LDO + h * VD;
#pragma unroll
  for (int r = 0; r < 16; ++r) { const int orow = crow(r, hi);
#pragma unroll
    for (int d0 = 0; d0 < 4; ++d0) { const float v = o[d0][r] * rli[r]; Ow[(size_t)orow * LDO + d0 * 32 + r32] = (bf16_t)(cvtpk(v, v) & 0xffffu); } }
  __syncthreads();
#undef TROW
#undef SLOAD
#undef SWRITE
#undef SWAIT
#undef RESC
}
#undef SBAR
}

constexpr size_t MiB = 1u << 20;
constexpr size_t WS_CTL = 0;
constexpr size_t WS_BAR = 16384, CTL_ZERO_BYTES = 65536;
constexpr size_t WS_SSQL = 128 * 1024;
constexpr size_t WS_MOD = 1 * MiB;
constexpr size_t WS_ROPE = WS_MOD + 512 * 1024;
constexpr size_t WS_STAT = 2 * MiB;
constexpr size_t WS_SSQ = WS_STAT + 512 * 1024;
constexpr size_t WS_BIAS = WS_MOD + 576 * 1024;
constexpr size_t WS_XC = 3 * MiB;
constexpr size_t WS_W = 8 * MiB;
constexpr size_t WS_W1 = WS_W, WS_W2 = WS_W + 8 * MiB, W_FFN_STRIDE = 16 * MiB;
constexpr size_t WS_MLA = WS_W + 64 * MiB, W_MLA_STRIDE = 6 * MiB;
constexpr size_t OFF_WQKVA = 0, OFF_WQB = 3 * MiB / 2, OFF_WKVB = 11 * MiB / 4, OFF_WO = 4 * MiB;
constexpr size_t WS_GM = WS_MLA + 2 * W_MLA_STRIDE, W_GM_STRIDE = 13 * MiB;
constexpr size_t OFF_WIN = 0, OFF_WOUT = 8 * MiB, OFF_WBLK = 12 * MiB;
constexpr size_t WS_H = WS_GM + 2 * W_GM_STRIDE;
constexpr size_t WS_QKVA = WS_H + 34 * MiB;
constexpr size_t WS_CQ = WS_QKVA + 51 * MiB;
constexpr size_t WS_CKV = WS_CQ + 13 * MiB;
constexpr size_t WS_BIG = WS_CKV + 9 * MiB;
constexpr size_t OFF_QRAW = 0, OFF_KVRAW = 51 * MiB, OFF_KPE = 119 * MiB;
constexpr size_t OFF_FFH = 0;
constexpr size_t OFF_GU = 0, OFF_GVT = 68 * MiB;
constexpr size_t WS_END = WS_BIG + 136 * MiB;
static_assert(WS_H == 110 * MiB && WS_END == 353 * MiB, "ws map");

constexpr int LDS_BYTES = 147456;
static_assert(att::SHM_ATTN <= pg8::STAGE_BYTES, "attention LDS fits the GEMM ring");

struct Args { const float* in[25]; float* out; unsigned char* ws; int ph_lo, ph_hi; };
enum { I_X = 0, I_C, I_CTX, I_CCTX, I_ADAW, I_ADAB, I_NMG, I_NFG, I_WQA, I_QAN, I_WQB, I_WKVA, I_KVAN, I_WKVB, I_QN, I_KN, I_WO,
       I_GWIN, I_GLNG, I_GLNB, I_GWS, I_GBS, I_GWOUT, I_W1, I_W2 };
typedef const __attribute__((address_space(4))) Args* KArgsP;
struct KA {
    KArgsP p;
    __device__ __forceinline__ const float* in(int i) const { return p->in[i]; }
    __device__ __forceinline__ float* out() const { return p->out; }
    __device__ __forceinline__ unsigned char* ws() const { return p->ws; }
};

__device__ __forceinline__ unsigned f2bf(float f) { unsigned u = __builtin_bit_cast(unsigned, f); return (u + 0x7fffu + ((u >> 16) & 1u)) >> 16; }
__device__ __forceinline__ unsigned pk2(float lo, float hi) { return f2bf(lo) | (f2bf(hi) << 16); }

__device__ __forceinline__ void p0_transpose_item(const float* W, int K, int N, bf16_t* WT, int row_off, LAS float* scr, int item, int lane) {
    const int nblk = N / 64, kb = item / nblk, nb = item % nblk, k0 = 64 * kb, n0 = 64 * nb;
    const int kq = lane >> 4, n4 = (lane & 15) * 4;
    f32x4 v[16];
    const float* src = W + (size_t)(k0 + kq) * N + n0 + n4;
#pragma unroll
    for (int i = 0; i < 16; ++i) v[i] = __builtin_nontemporal_load((const f32x4*)(src + (size_t)(4 * i) * N));
#pragma unroll
    for (int i = 0; i < 16; ++i) { LAS float* d = scr + (4 * i + kq) * 65 + n4; d[0] = v[i].x; d[1] = v[i].y; d[2] = v[i].z; d[3] = v[i].w; }
    asm volatile("s_waitcnt lgkmcnt(0)" ::: "memory");
    const int c = lane & 7;
#pragma unroll
    for (int j = 0; j < 8; ++j) { const int n = (lane >> 3) + 8 * j; const LAS float* s = scr + (8 * c) * 65 + n;
        u32x4 o; o.x = cvt_pk_bf16(s[0 * 65], s[1 * 65]); o.y = cvt_pk_bf16(s[2 * 65], s[3 * 65]); o.z = cvt_pk_bf16(s[4 * 65], s[5 * 65]); o.w = cvt_pk_bf16(s[6 * 65], s[7 * 65]);
        *(u32x4*)(WT + (size_t)(row_off + n0 + n) * K + k0 + 8 * c) = o; }
    asm volatile("s_waitcnt lgkmcnt(0)" ::: "memory");
}

__device__ __forceinline__ void p0_phase(const KA a, unsigned char* ws, LAS unsigned char* lds, int bx, int G, int tid, int wave, int lane, int rep_ = 0) {
    LAS float* sil = (LAS float*)lds;
    LAS float* red = (LAS float*)(lds + 20480);
    for (int it = bx; it < 4 * 24; it += G) {
        const int l = it / 24, cg_ = it % 24, col0 = cg_ * 256;
        for (int i = tid; i < 5 * 1024; i += 512) { const int b = i >> 10, k = i & 1023; const float v = b < 4 ? a.in(I_C)[b * 1024 + k] : a.in(I_CCTX)[k]; sil[i] = v / (1.f + __expf(-v)); }
        __syncthreads();
        f32x4 acc[5];
#pragma unroll
        for (int b = 0; b < 5; ++b) acc[b] = (f32x4){0.f, 0.f, 0.f, 0.f};
        const float* W = a.in(I_ADAW) + (size_t)l * 1024 * NMOD + col0 + 4 * lane;
#pragma unroll 16
        for (int kk = 0; kk < 128; ++kk) { const int k = wave * 128 + kk; const f32x4 w = __builtin_nontemporal_load((const f32x4*)(W + (size_t)k * NMOD));
#pragma unroll
            for (int b = 0; b < 5; ++b) acc[b] += w * sil[b * 1024 + k]; }
#pragma unroll
        for (int b = 0; b < 5; ++b) *(LAS f32x4*)(red + (wave * 5 + b) * 256 + 4 * lane) = acc[b];
        __syncthreads();
        for (int i = tid; i < 5 * 256; i += 512) { const int b = i >> 8, c = i & 255; float s = a.in(I_ADAB)[l * NMOD + col0 + c];
#pragma unroll
            for (int w = 0; w < 8; ++w) s += red[(w * 5 + b) * 256 + c];
            ((float*)(ws + WS_MOD))[((size_t)l * 5 + b) * NMOD + col0 + c] = s; }
        __syncthreads();
    }
    const int gt = bx * 512 + tid, NT = G * 512;
    if (bx == G - 1) { for (int i = tid; i < 1024; i += 512) { const int pos = i >> 4, f = i & 15; const float inv = powf(10000.f, -(float)(2 * f) / 32.f), ang = (float)pos * inv;
        ((float*)(ws + WS_ROPE))[i] = cosf(ang); ((float*)(ws + WS_ROPE))[1024 + i] = sinf(ang); } }
    for (int i = gt; i < 2 * 2 * MALL; i += NT) ((float*)(ws + WS_STAT))[i] = 0.f;
    for (int i = gt; i < 8 * MLAT; i += NT) ((float*)(ws + WS_SSQ))[i] = 0.f;
    for (int i = gt; i < 6 * MALL; i += NT) ((float*)(ws + WS_CTL + WS_SSQL))[i] = 0.f;
    for (int i = gt; i < 2 * 64 * 1024 / 8; i += NT) { const int j = i / (64 * 1024 / 8), r = i % (64 * 1024 / 8);
        *(u32x4*)(ws + WS_MLA + j * W_MLA_STRIDE + OFF_WQKVA + (size_t)704 * 1024 * 2 + (size_t)r * 16) = (u32x4){0u, 0u, 0u, 0u}; }
    for (int i = gt; i < 2 * 8 * 256 * 256 / 2; i += NT) {
        const int e = i * 2, j = e / (8 * 65536), g = (e / 65536) % 8, rr = (e / 256) % 256, cc = e % 256;
        unsigned w = 0u;
        if ((rr >> 7) == (cc >> 7)) { const float* s = a.in(I_GWS) + (((size_t)j * 8 + g) * 128 + (rr & 127)) * 128 + (cc & 127); w = pk2(s[0], s[1]); }
        *(unsigned*)(ws + WS_GM + j * W_GM_STRIDE + OFF_WBLK + (size_t)(e % (8 * 65536)) * 2) = w; }
    LAS float* scr = (LAS float*)(lds + wave * 16640);
    unsigned* ctr = (unsigned*)(ws + WS_CTL) + 64 * rep_;
    constexpr int I_FF = 1024, I_QA = 96, I_KVA = 80, I_QB = 144, I_KVB = 128, I_OO = 256, I_MLA = I_QA + I_KVA + I_QB + I_KVB + I_OO, I_IN = 1024, I_OUT = 512, I_GMI = I_IN + I_OUT;
    constexpr int NITEMS = 4 * 2 * I_FF + 2 * I_MLA + 2 * I_GMI;
    static_assert(NITEMS % 4 == 0, "items are dequeued four at a time");
    for (int sub = 0, it0 = 0;; ++sub) {
        if ((sub & 3) == 0) { int t = 0; if (lane == 0) t = (int)atomicAdd(ctr, 4u); it0 = __builtin_amdgcn_readfirstlane(t); }
        int it = it0 + (sub & 3);
        if (it >= NITEMS) break;
        if (it < 4 * 2 * I_FF) { const int l = it / (2 * I_FF), r = it % (2 * I_FF);
            if (r < I_FF) p0_transpose_item(a.in(I_W1) + (size_t)l * DM * FFH, DM, FFH, (bf16_t*)(ws + WS_W1 + l * W_FFN_STRIDE), 0, scr, r, lane);
            else p0_transpose_item(a.in(I_W2) + (size_t)l * DM * FFH, FFH, DM, (bf16_t*)(ws + WS_W2 + l * W_FFN_STRIDE), 0, scr, r - I_FF, lane);
            continue; }
        it -= 4 * 2 * I_FF;
        if (it < 2 * I_MLA) { const int j = it / I_MLA; int r = it % I_MLA; unsigned char* wb = ws + WS_MLA + j * W_MLA_STRIDE;
            if (r < I_QA) { p0_transpose_item(a.in(I_WQA) + (size_t)j * DM * QLORA, DM, QLORA, (bf16_t*)(wb + OFF_WQKVA), 0, scr, r, lane); continue; } r -= I_QA;
            if (r < I_KVA) { p0_transpose_item(a.in(I_WKVA) + (size_t)j * DM * 320, DM, 320, (bf16_t*)(wb + OFF_WQKVA), 384, scr, r, lane); continue; } r -= I_KVA;
            if (r < I_QB) { p0_transpose_item(a.in(I_WQB) + (size_t)j * QLORA * 1536, QLORA, 1536, (bf16_t*)(wb + OFF_WQB), 0, scr, r, lane); continue; } r -= I_QB;
            if (r < I_KVB) { p0_transpose_item(a.in(I_WKVB) + (size_t)j * KVLORA * 2048, KVLORA, 2048, (bf16_t*)(wb + OFF_WKVB), 0, scr, r, lane); continue; } r -= I_KVB;
            p0_transpose_item(a.in(I_WO) + (size_t)j * DM * DM, DM, DM, (bf16_t*)(wb + OFF_WO), 0, scr, r, lane); continue; }
        it -= 2 * I_MLA;
        { const int j = it / I_GMI, r = it % I_GMI; unsigned char* wb = ws + WS_GM + j * W_GM_STRIDE;
            if (r < I_IN) p0_transpose_item(a.in(I_GWIN) + (size_t)j * DM * 4096, DM, 4096, (bf16_t*)(wb + OFF_WIN), 0, scr, r, lane);
            else p0_transpose_item(a.in(I_GWOUT) + (size_t)j * GMH * DM, GMH, DM, (bf16_t*)(wb + OFF_WOUT), 0, scr, r - I_IN, lane); }
    }
}

__device__ __forceinline__ void modulate_row(int r, const float* xlat, const float* xctx, const float* gain, const float* modl, int sh_off, int sc_off, bf16_t* H, int lane,
                                             const float* slab, int nslab, float* xc_out) {
    const bool lat = r < MLAT; const float* xr = lat ? xlat + (size_t)r * DM : xctx + (size_t)(r - MLAT) * DM; const int b = lat ? (r >> 12) : 4;
    const float* mp = modl + (size_t)b * NMOD;
    f32x4 v[4]; float s = 0.f;
#pragma unroll
    for (int j = 0; j < 4; ++j) v[j] = *(const f32x4*)(xr + 4 * lane + 256 * j);
    if (!lat && nslab > 0) {
        for (int t0 = 0; t0 < nslab; t0 += 4) {
            f32x4 sv[4][4];
#pragma unroll
            for (int t = 0; t < 4; ++t) { const float* sp = slab + ((size_t)(t0 + t) * MCTX + (r - MLAT)) * DM + 4 * lane;
#pragma unroll
                for (int j = 0; j < 4; ++j) sv[t][j] = *(const f32x4*)(sp + 256 * j); }
#pragma unroll
            for (int t = 0; t < 4; ++t)
#pragma unroll
                for (int j = 0; j < 4; ++j) v[j] += sv[t][j]; }
#pragma unroll
        for (int j = 0; j < 4; ++j) *(f32x4*)(xc_out + (size_t)(r - MLAT) * DM + 4 * lane + 256 * j) = v[j];
    }
#pragma unroll
    for (int j = 0; j < 4; ++j) s += (v[j].x * v[j].x + v[j].y * v[j].y) + (v[j].z * v[j].z + v[j].w * v[j].w);
    const float rinv = 1.0f / sqrtf(wave_sum(s, lane) * (1.f / DM) + EPS);
#pragma unroll
    for (int j = 0; j < 4; ++j) { const int c = 4 * lane + 256 * j; const f32x4 g = *(const f32x4*)(gain + c), sc = *(const f32x4*)(mp + sc_off + c), sh = *(const f32x4*)(mp + sh_off + c);
        const f32x4 y = (v[j] * rinv) * g * (sc + 1.0f) + sh;
        u32x2 w; w.x = cvt_pk_bf16(y[0], y[1]); w.y = cvt_pk_bf16(y[2], y[3]); *(u32x2*)(H + (size_t)r * DM + c) = w; }
}
template <int NR> __device__ __forceinline__ void modulate_rows(const int (&rows)[NR], const float* xlat, const float* xctx, const float* gain, const float* modl, int sh_off, int sc_off, bf16_t* H, int lane) {
    f32x4 v[NR][4]; float s[NR];
#pragma unroll
    for (int k = 0; k < NR; ++k) { const int r = rows[k]; const float* xr = r < MLAT ? xlat + (size_t)r * DM : xctx + (size_t)(r - MLAT) * DM;
#pragma unroll
        for (int j = 0; j < 4; ++j) v[k][j] = __builtin_nontemporal_load((const f32x4*)(xr + 4 * lane + 256 * j)); }
#pragma unroll
    for (int k = 0; k < NR; ++k) { s[k] = 0.f;
#pragma unroll
        for (int j = 0; j < 4; ++j) s[k] += (v[k][j].x * v[k][j].x + v[k][j].y * v[k][j].y) + (v[k][j].z * v[k][j].z + v[k][j].w * v[k][j].w); }
#pragma unroll
    for (int o = 1; o < 64; o <<= 1)
#pragma unroll
        for (int k = 0; k < NR; ++k) s[k] += shx(s[k], o, lane);
#pragma unroll
    for (int k = 0; k < NR; ++k) { const int r = rows[k]; const float rinv = 1.0f / sqrtf(s[k] * (1.f / DM) + EPS); const float* mp = modl + (size_t)(r < MLAT ? (r >> 12) : 4) * NMOD;
#pragma unroll
        for (int j = 0; j < 4; ++j) { const int c = 4 * lane + 256 * j; const f32x4 g = *(const f32x4*)(gain + c), sc = *(const f32x4*)(mp + sc_off + c), sh = *(const f32x4*)(mp + sh_off + c);
            const f32x4 y = (v[k][j] * rinv) * g * (sc + 1.0f) + sh;
            u32x2 w; w.x = cvt_pk_bf16(y[0], y[1]); w.y = cvt_pk_bf16(y[2], y[3]); *(u32x2*)(H + (size_t)r * DM + c) = w; } }
}
__device__ __forceinline__ void modulate_phase(const float* xlat, const float* xctx, const float* gain, const float* modl, int sh_off, int sc_off, bf16_t* H, int nrows, int gw, int NGW, int lane,
                                               const float* slab = nullptr, int nslab = 0, float* xc_out = nullptr) {
    if (nslab > 0 && nrows == MALL && NGW == 2048) {
        const int nA = nslab >= 8 ? 4 : 6, p = gw & 1023, i0 = gw < 1024 ? 0 : nA, i1 = gw < 1024 ? nA : 16;
        if (gw < 1024) modulate_row(MLAT + gw, xlat, xctx, gain, modl, sh_off, sc_off, H, lane, slab, nslab, xc_out);
        for (int i = i0; i < i1; i += 2) { const int rows[2] = {p * 16 + i, p * 16 + i + 1}; modulate_rows<2>(rows, xlat, xctx, gain, modl, sh_off, sc_off, H, lane); }
    } else if (nslab > 0) {
        for (int r = gw; r < nrows; r += NGW) modulate_row(r, xlat, xctx, gain, modl, sh_off, sc_off, H, lane, slab, nslab, xc_out);
    } else {
        int r = gw;
        for (; r + 3 * NGW < nrows; r += 4 * NGW) { const int rows[4] = {r, r + NGW, r + 2 * NGW, r + 3 * NGW}; modulate_rows<4>(rows, xlat, xctx, gain, modl, sh_off, sc_off, H, lane); }
        for (; r < nrows; r += NGW) { const int rows[1] = {r}; modulate_rows<1>(rows, xlat, xctx, gain, modl, sh_off, sc_off, H, lane); }
    }
}
__device__ __forceinline__ void modulate_ctx_phase(const float* xctx, const float* gain, const float* modl, int sh_off, int sc_off, bf16_t* H, int gw, int NGW, int lane, const float* slab, int nslab, float* xc_out) {
    for (int rr = gw; rr < MCTX; rr += NGW) modulate_row(MLAT + rr, nullptr, xctx, gain, modl, sh_off, sc_off, H, lane, slab, nslab, xc_out);
}
__device__ __forceinline__ void shift_bias_rows(const bf16_t* Wt, int nrows, const float* shift  , float* out, int ldo, int w0, int wstep, int lane) {
    f32x4 sh[4][4];
#pragma unroll
    for (int b = 0; b < 4; ++b)
#pragma unroll
        for (int q = 0; q < 4; ++q) sh[b][q] = *(const f32x4*)(shift + (size_t)b * NMOD + 16 * lane + 4 * q);
    for (int n0 = w0; n0 < nrows; n0 += 2 * wstep) {
        const int n1 = n0 + wstep; const bool has1 = n1 < nrows; const int n1c = has1 ? n1 : n0;
        float wv[2][16];
        unpack8(*(const u32x4*)(Wt + (size_t)n0 * DM + 16 * lane), wv[0]); unpack8(*(const u32x4*)(Wt + (size_t)n0 * DM + 16 * lane + 8), wv[0] + 8);
        unpack8(*(const u32x4*)(Wt + (size_t)n1c * DM + 16 * lane), wv[1]); unpack8(*(const u32x4*)(Wt + (size_t)n1c * DM + 16 * lane + 8), wv[1] + 8);
        float d[2][4];
#pragma unroll
        for (int u = 0; u < 2; ++u)
#pragma unroll
            for (int b = 0; b < 4; ++b) { float s = 0.f;
#pragma unroll
                for (int q = 0; q < 4; ++q) s += (sh[b][q][0] * wv[u][4 * q] + sh[b][q][1] * wv[u][4 * q + 1]) + (sh[b][q][2] * wv[u][4 * q + 2] + sh[b][q][3] * wv[u][4 * q + 3]);
                d[u][b] = s; }
#pragma unroll
        for (int o = 1; o < 64; o <<= 1)
#pragma unroll
            for (int u = 0; u < 2; ++u)
#pragma unroll
                for (int b = 0; b < 4; ++b) d[u][b] += shx(d[u][b], o, lane);
        if (lane < 4) { out[(size_t)lane * ldo + n0] = lane == 0 ? d[0][0] : lane == 1 ? d[0][1] : lane == 2 ? d[0][2] : d[0][3];
            if (has1) out[(size_t)lane * ldo + n1] = lane == 0 ? d[1][0] : lane == 1 ? d[1][1] : lane == 2 ? d[1][2] : d[1][3]; }
    }
}
__device__ __forceinline__ void lora_norm_phase(const float* qkva, const float* qan, const float* kvan, bf16_t* CQ, bf16_t* CKV, int nrows, int gw, int NGW, int lane) {
    for (int r = gw; r < nrows; r += NGW) {
        const float* p = qkva + (size_t)r * NQKVA;
        f32x2 q[3]; float s = 0.f;
#pragma unroll
        for (int j = 0; j < 3; ++j) { q[j] = *(const f32x2*)(p + 2 * lane + 128 * j); s += q[j].x * q[j].x + q[j].y * q[j].y; }
        const f32x4 kv = *(const f32x4*)(p + 384 + 4 * lane); const float s2 = (kv.x * kv.x + kv.y * kv.y) + (kv.z * kv.z + kv.w * kv.w);
        const float rq = 1.0f / sqrtf(wave_sum(s, lane) * (1.f / QLORA) + EPS), rk = 1.0f / sqrtf(wave_sum(s2, lane) * (1.f / KVLORA) + EPS);
#pragma unroll
        for (int j = 0; j < 3; ++j) { const int c = 2 * lane + 128 * j; const f32x2 g = *(const f32x2*)(qan + c); *(unsigned*)(CQ + (size_t)r * QLORA + c) = cvt_pk_bf16(q[j].x * rq * g.x, q[j].y * rq * g.y); }
        { const int c = 4 * lane; const f32x4 g = *(const f32x4*)(kvan + c); u32x2 w; w.x = cvt_pk_bf16(kv.x * rk * g.x, kv.y * rk * g.y); w.y = cvt_pk_bf16(kv.z * rk * g.z, kv.w * rk * g.w);
          *(u32x2*)(CKV + (size_t)r * KVLORA + c) = w; }
    }
}
__device__ __forceinline__ void qk_norm_rope_phase(bf16_t* Qraw, bf16_t* KVraw, bf16_t* KPE, const float* qkva, const float* qn, const float* kn, const float* rope, int nrows_q, int nrows, int gw, int NGW, int lane) {
    (void)Qraw; (void)qn; (void)nrows_q;
    const int h = lane >> 3, sub = lane & 7, fbase = (sub & 1) * 8;
    float gkn[16], gkp[8];
#pragma unroll
    for (int i = 0; i < 16; ++i) gkn[i] = kn[16 * sub + i];
#pragma unroll
    for (int i = 0; i < 8; ++i) gkp[i] = kn[128 + 8 * sub + i];
    for (int r0 = gw; r0 < nrows; r0 += 2 * NGW) {
        u32x4 xa[2][2]; f32x4 ka_[2][2], cv[2][2], sv[2][2]; int rr[2]; bool ok[2];
#pragma unroll
        for (int u = 0; u < 2; ++u) { const int r = r0 + u * NGW; ok[u] = r < nrows; rr[u] = ok[u] ? r : r0;
            const bf16_t* p = KVraw + (size_t)rr[u] * (NH * 256) + h * 256 + 16 * sub; xa[u][0] = *(const u32x4*)p; xa[u][1] = *(const u32x4*)(p + 8);
            const float* kp = qkva + (size_t)rr[u] * NQKVA + 640 + 8 * sub; ka_[u][0] = *(const f32x4*)kp; ka_[u][1] = *(const f32x4*)(kp + 4);
            const int s = rr[u] & (SEQ - 1), pos = (sub < 4) ? (s >> 6) : (s & 63); const float* cp = rope + pos * 16 + fbase;
            cv[u][0] = *(const f32x4*)cp; cv[u][1] = *(const f32x4*)(cp + 4); sv[u][0] = *(const f32x4*)(cp + 1024); sv[u][1] = *(const f32x4*)(cp + 1028); }
#pragma unroll
        for (int u = 0; u < 2; ++u) { if (!ok[u]) continue;
            const int r = rr[u]; const bool lat = r < MLAT;
            float x[16], y[8]; unpack8(xa[u][0], x); unpack8(xa[u][1], x + 8);
#pragma unroll
            for (int i = 0; i < 8; ++i) y[i] = ka_[u][i >> 2][i & 3];
            float ss = 0.f;
#pragma unroll
            for (int i = 0; i < 16; ++i) ss += x[i] * x[i];
#pragma unroll
            for (int i = 0; i < 8; ++i) ss += y[i] * y[i];
            ss += shx(ss, 1, lane); ss += shx(ss, 2, lane); ss += shx(ss, 4, lane);
            const float rinv = 1.0f / sqrtf(ss * (1.f / QKD) + EPS);
#pragma unroll
            for (int i = 0; i < 16; ++i) x[i] = x[i] * rinv * gkn[i];
            float z[8];
#pragma unroll
            for (int i = 0; i < 8; ++i) { y[i] = y[i] * rinv * gkp[i]; const float o = shx(y[i], 2, lane); const float c = lat ? cv[u][i >> 2][i & 3] : 1.f, sn = lat ? sv[u][i >> 2][i & 3] : 0.f;
                z[i] = y[i] * c + ((sub & 2) ? o : -o) * sn; }
            bf16_t* p = KVraw + (size_t)r * (NH * 256) + h * 256 + 16 * sub;
            *(u32x4*)p = pack8(x); *(u32x4*)(p + 8) = pack8(x + 8);
            *(u32x4*)(KPE + (size_t)r * (NH * QKR) + h * QKR + 8 * sub) = pack8(z); }
    }
}
__device__ __forceinline__ void gm_ln_phase(bf16_t* Vt, const float* S1, const float* S2, const float* lng, const float* lnb, int ntok, int gt, int NT) {
    const int per_row = ntok / 8, cstride = NT / per_row;
    const int tg = gt % per_row, c0 = gt / per_row;
    if (c0 >= cstride) return;
    const int t0 = tg * 8;
    float mu[8], rs[8];
    { const f32x4 a0 = *(const f32x4*)(S1 + t0), a1 = *(const f32x4*)(S1 + t0 + 4), b0 = *(const f32x4*)(S2 + t0), b1 = *(const f32x4*)(S2 + t0 + 4);
#pragma unroll
      for (int e = 0; e < 8; ++e) { const float s1 = e < 4 ? a0[e & 3] : a1[e & 3], s2 = e < 4 ? b0[e & 3] : b1[e & 3]; mu[e] = s1 * (1.f / GMH); rs[e] = 1.0f / sqrtf(fmaxf(s2 * (1.f / GMH) - mu[e] * mu[e], 0.f) + EPS); } }
    for (int c = c0; c < GMH; c += 4 * cstride) {
        u32x4 raw[4];
#pragma unroll
        for (int u = 0; u < 4; ++u) { const int cc = c + u * cstride; if (cc < GMH) raw[u] = *(const u32x4*)(Vt + (size_t)cc * MALL + t0); }
#pragma unroll
        for (int u = 0; u < 4; ++u) { const int cc = c + u * cstride; if (cc < GMH) { float x[8]; unpack8(raw[u], x); const float g = lng[cc], b = lnb[cc];
#pragma unroll
            for (int e = 0; e < 8; ++e) x[e] = (x[e] - mu[e]) * (rs[e] * g) + b;
            *(u32x4*)(Vt + (size_t)cc * MALL + t0) = pack8(x); } }
    }
}

__device__ __forceinline__ void gm_ln_block(bf16_t* Vt, const float* S1, const float* S2, const float* lng, const float* lnb, int c0, int t0, int tid) {
    const int tt = t0 + (tid & 31) * 8, r0 = tid >> 5;
    float mu[8], rs[8];
    { const f32x4 a0 = *(const f32x4*)(S1 + tt), a1 = *(const f32x4*)(S1 + tt + 4), b0 = *(const f32x4*)(S2 + tt), b1 = *(const f32x4*)(S2 + tt + 4);
#pragma unroll
      for (int e = 0; e < 8; ++e) { const float s1 = e < 4 ? a0[e & 3] : a1[e & 3], s2 = e < 4 ? b0[e & 3] : b1[e & 3]; mu[e] = s1 * (1.f / GMH); rs[e] = 1.0f / sqrtf(fmaxf(s2 * (1.f / GMH) - mu[e] * mu[e], 0.f) + EPS); } }
#pragma unroll
    for (int k0 = 0; k0 < 16; k0 += 8) {
        u32x4 raw[8];
#pragma unroll
        for (int k = 0; k < 8; ++k) raw[k] = *(const u32x4*)(Vt + (size_t)(c0 + r0 + 16 * (k0 + k)) * MALL + tt);
#pragma unroll
        for (int k = 0; k < 8; ++k) { const int c = c0 + r0 + 16 * (k0 + k); float x[8]; unpack8(raw[k], x); const float g = lng[c], b = lnb[c];
#pragma unroll
            for (int e = 0; e < 8; ++e) x[e] = (x[e] - mu[e]) * (rs[e] * g) + b;
            *(u32x4*)(Vt + (size_t)c * MALL + tt) = pack8(x); }
    }
}

#define XB_TMO      128
#define XB_XCNT(j)  (256  + 64 * (j))
#define XB_XSUB(j)  (1280 + 64 * (j))
#define XB_XGEN(j)  (2304 + 64 * (j))
#define XB_TOP      3328
#define XB_TOPGEN   3392
#define XCD_BAR_WORDS 3456
#define XB_SPIN_CAP (1u << 18)

__device__ __forceinline__ unsigned xb_ld(unsigned* p)              { return __hip_atomic_load(p, __ATOMIC_RELAXED, __HIP_MEMORY_SCOPE_AGENT); }
__device__ __forceinline__ unsigned xb_add(unsigned* p, unsigned v) { return __hip_atomic_fetch_add(p, v, __ATOMIC_RELAXED, __HIP_MEMORY_SCOPE_AGENT); }
__device__ __forceinline__ unsigned xb_xcc_id() { return (unsigned)__builtin_amdgcn_s_getreg((3 << 11) | 20) & 0xFu; }
#define XB_SPIN(cond, bar) do { unsigned _sp = 0; while (cond) { __builtin_amdgcn_s_sleep(1); \
    if ((++_sp & 255u) == 0u) { if (xb_ld(&(bar)[XB_TMO])) break; if (_sp > XB_SPIN_CAP) { atomicAdd(&(bar)[XB_TMO], 1u); break; } } } } while (0)

struct XcdBarrier {
    unsigned* bar; unsigned x;
    volatile LAS unsigned* st;
};

__device__ __forceinline__ XcdBarrier xcd_barrier_post(unsigned* bar, volatile LAS unsigned* st) {
    XcdBarrier b; b.bar = bar; b.x = xb_xcc_id(); b.st = st;
    if (threadIdx.x == 0) (void)xb_add(&bar[XB_XCNT(b.x)], 1u);
    return b;
}
__device__ __forceinline__ void xcd_barrier_complete(unsigned* bar, unsigned x, unsigned& nloc, unsigned& nx) {
    const unsigned G = gridDim.x * gridDim.y * gridDim.z;
    unsigned sum, cnt, mine, sp = 0u;
    for (;;) {
        sum = 0u; cnt = 0u; mine = 0u;
#pragma unroll
        for (unsigned j = 0; j < 16; ++j) { const unsigned c = xb_ld(&bar[XB_XCNT(j)]); sum += c; cnt += (c > 0u) ? 1u : 0u; mine = (j == x) ? c : mine; }
        if (sum == G) break;
        __builtin_amdgcn_s_sleep(1);
        if ((++sp & 255u) == 0u) { if (xb_ld(&bar[XB_TMO])) break; if (sp > XB_SPIN_CAP) { atomicAdd(&bar[XB_TMO], 1u); break; } }
    }
    nloc = mine > 0u ? mine : 1u; nx = cnt > 0u ? cnt : 1u;
}

__device__ __forceinline__ void xcd_barrier(const XcdBarrier& b) {
    asm volatile("s_waitcnt vmcnt(0)" ::: "memory");
    __syncthreads();
    if (threadIdx.x == 0) {
        unsigned* bar = b.bar;
        __builtin_amdgcn_s_waitcnt(0);
        unsigned nloc = b.st[0], nx = b.st[1];
        if (nloc == 0u) { xcd_barrier_complete(bar, b.x, nloc, nx); b.st[0] = nloc; b.st[1] = nx; }
        const unsigned old = xb_add(&bar[XB_XSUB(b.x)], 1u);
        const unsigned gen = old / nloc;
        if (old + 1u == (gen + 1u) * nloc) {
            __builtin_amdgcn_fence(__ATOMIC_RELEASE, "agent");
            asm volatile("s_waitcnt vmcnt(0)" ::: "memory");
            const unsigned og = xb_add(&bar[XB_TOP], 1u);
            const unsigned tg = og / nx;
            if (og + 1u == (tg + 1u) * nx) xb_add(&bar[XB_TOPGEN], 1u);
            else XB_SPIN(xb_ld(&bar[XB_TOPGEN]) == tg, bar);
            __builtin_amdgcn_fence(__ATOMIC_ACQUIRE, "agent");
            xb_add(&bar[XB_XGEN(b.x)], 1u);
            asm volatile("s_waitcnt vmcnt(0)" ::: "memory");
        } else {
            XB_SPIN(xb_ld(&bar[XB_XGEN(b.x)]) == gen, bar);
            __builtin_amdgcn_fence(__ATOMIC_ACQUIRE, "agent");
            asm volatile("s_waitcnt vmcnt(0)" ::: "memory");
        }
    }
    __syncthreads();
}

__global__ void __launch_bounds__(512, 2) fwd_mega(Args a_unused) {
    extern __shared__ __attribute__((aligned(16))) unsigned char lds_raw[];
    LAS unsigned char* lds = (LAS unsigned char*)lds_raw;
    cg::grid_group grid = cg::this_grid();
    const KArgsP ap0 = (KArgsP)__builtin_amdgcn_kernarg_segment_ptr();
    const int lo = ap0->ph_lo, hi = ap0->ph_hi;
    int ph = 0;
    volatile LAS unsigned* bst = (volatile LAS unsigned*)(lds + LDS_BYTES - 64);
    if (threadIdx.x < 2) bst[threadIdx.x] = 0u;
    __syncthreads();
    if (hi - lo > 1) (void)xcd_barrier_post((unsigned*)(ap0->ws + WS_CTL + WS_BAR), bst);
#define PHASE_BEGIN if (lo <= ph && ph < hi) { int tid = threadIdx.x; asm volatile("" : "+v"(tid));   \
    KA ka; { KArgsP ap_ = ap0; asm volatile("" : "+s"(ap_)); ka.p = ap_; } unsigned char* const ws = ka.ws(); \
    int G = gridDim.x, bx = blockIdx.x; asm volatile("" : "+s"(G), "+s"(bx)); \
    const int vcu = (G % 8 == 0) ? (bx % 8) * (G / 8) + bx / 8 : bx;       \
    const int NGW = G * 8, NTH = G * 512; \
    const int lane = tid & 63, wave = __builtin_amdgcn_readfirstlane(tid >> 6), gw = vcu * 8 + wave, gt = bx * 512 + tid; (void)lane; (void)wave; (void)gw; (void)gt; (void)ws; (void)NGW; (void)NTH;
#define PHASE_END   if (ph + 1 < hi) { if (hi > 4096) grid.sync();   else { XcdBarrier xb_; xb_.bar = (unsigned*)(ws + WS_CTL + WS_BAR); xb_.x = xb_xcc_id(); xb_.st = bst; for (int rb_ = 0; rb_ < REP_BAR; ++rb_) xcd_barrier(xb_); } } } ++ph;
#define XLAT ((l == 0) ? ka.in(I_X) : (const float*)ka.out())
#define XCTX ((l == 0) ? ka.in(I_CTX) : (const float*)(ws + WS_XC))
#define XC_ ((float*)(ws + WS_XC))
#define MODL ((const float*)(ws + WS_MOD) + (size_t)l * 5 * NMOD)
#define HB_ ((bf16_t*)(ws + WS_H))
#define WB_MLA (ws + WS_MLA + j * W_MLA_STRIDE)
#define WB_GM (ws + WS_GM + j * W_GM_STRIDE)
#define QKVA_ ((float*)(ws + WS_QKVA))
#define CQ_ ((bf16_t*)(ws + WS_CQ))
#define CKV_ ((bf16_t*)(ws + WS_CKV))
#define QRAW_ ((bf16_t*)(ws + WS_BIG + OFF_QRAW))
#define KVRAW_ ((bf16_t*)(ws + WS_BIG + OFF_KVRAW))
#define KPE_ ((bf16_t*)(ws + WS_BIG + OFF_KPE))
#define GU_ ((bf16_t*)(ws + WS_BIG + OFF_GU))
#define GVT_ ((bf16_t*)(ws + WS_BIG + OFF_GVT))
#define S1_ ((float*)(ws + WS_STAT) + (size_t)j * 2 * MALL)
#define S2_ (S1_ + MALL)
#define FH_ ((bf16_t*)(ws + WS_BIG + OFF_FFH))
#define SSQQ_ ((float*)(ws + WS_CTL + WS_SSQL) + (size_t)j * 2 * MALL)
#define SSQKV_ (SSQQ_ + MALL)
#define SSQKP_ ((float*)(ws + WS_CTL + WS_SSQL) + (size_t)(4 + j) * MALL)
#define O_ ((bf16_t*)(ws + WS_QKVA + 16 * MiB))
#define SSQ_(ll, which) ((float*)(ws + WS_SSQ) + (size_t)(2 * (ll) + (which)) * MLAT)
#define BIAS_F(ll) ((float*)(ws + WS_BIAS) + (size_t)(ll) * 4 * FFH)
#define BIAS_M(ll) ((float*)(ws + WS_BIAS) + (size_t)16 * FFH + ((ll) == 1 ? 0 : (ll) == 3 ? 4 * FFH : 8 * FFH))
#define MODN ((const float*)(ws + WS_MOD) + (size_t)(l + 1) * 5 * NMOD)
#define SLAB_ ((float*)(ws + WS_QKVA))

#define CTX_SPLIT_GEMM(Aptr, KTOT, Wptr, NSPLIT, GATEOFF) do { pg8::Gemm g2 = pg8::plain_gemm(Aptr, KTOT, Wptr, KTOT, (KTOT) / (NSPLIT)); g2.sAk = (size_t)((KTOT) / (NSPLIT)) * 2; g2.sBk = g2.sAk; \
    pg8::SplitOrder S2; S2.init(NSPLIT, G, G - 1 - bx); pg8::EpiSlab E2{SLAB_, MODL + (GATEOFF)}; pg8::gemm_phase<pg8::EpiSlab, pg8::SplitOrder, true, true>(lds, g2, S2, E2); } while (0)
    PHASE_BEGIN
#ifndef NO_P0
    for (int rep_ = 0; rep_ < REP_P0; ++rep_) { p0_phase(ka, ws, lds, bx, G, tid, wave, lane, rep_); __syncthreads(); }
#endif
    PHASE_END

    for (int l = 0; l < DEPTH; ++l) {
        const int j = l >> 1;
        const bool mla = (l & 1) == 0;
        const int Mrows = (l <= 2) ? MALL : MLAT;
        const int Mres = (l <= 1) ? MALL : MLAT;
        if (mla) {
            const int Mq = (l == 0) ? MALL : MLAT;
            PHASE_BEGIN
            if (l == 0) { modulate_phase(XLAT, XCTX, ka.in(I_NMG) + l * DM, MODL, 0, DM, HB_, Mrows, gw, NGW, lane);
                const float* mods = (const float*)(ws + WS_MOD);
                for (int ll = 0; ll < DEPTH; ++ll) shift_bias_rows((const bf16_t*)(ws + WS_W1 + ll * W_FFN_STRIDE), FFH, mods + (size_t)ll * 5 * NMOD + 3 * DM, (float*)(ws + WS_BIAS) + (size_t)ll * 4 * FFH, FFH, gw, NGW, lane);
                shift_bias_rows((const bf16_t*)(ws + WS_GM + 0 * W_GM_STRIDE + OFF_WIN), 2 * GMH, mods + (size_t)1 * 5 * NMOD, (float*)(ws + WS_BIAS) + (size_t)16 * FFH, 2 * GMH, gw, NGW, lane);
                shift_bias_rows((const bf16_t*)(ws + WS_GM + 1 * W_GM_STRIDE + OFF_WIN), 2 * GMH, mods + (size_t)3 * 5 * NMOD, (float*)(ws + WS_BIAS) + (size_t)16 * FFH + 4 * FFH, 2 * GMH, gw, NGW, lane);
                shift_bias_rows((const bf16_t*)(ws + WS_MLA + 1 * W_MLA_STRIDE + OFF_WQKVA), NQKVA, mods + (size_t)2 * 5 * NMOD, (float*)(ws + WS_BIAS) + (size_t)16 * FFH + 8 * FFH, NQKVA, gw, NGW, lane);
            } else modulate_ctx_phase(XCTX, ka.in(I_NMG) + l * DM, MODL, 0, DM, HB_, gw, NGW, lane, SLAB_, 8, XC_);
            PHASE_END
            PHASE_BEGIN for (int rep_ = 0; rep_ < REP_M24; ++rep_) { pg8::Gemm g = pg8::plain_gemm(HB_, DM, (const bf16_t*)(WB_MLA + OFF_WQKVA), DM, DM); pg8::StaticOrder S; S.init(Mrows, NQKVA, G, bx);
                pg8::EpiQKVA E{CQ_, CKV_, QKVA_, ka.in(I_QAN) + j * QLORA, ka.in(I_KVAN) + j * KVLORA, SSQQ_, SSQKV_, SSQKP_, l == 0 ? nullptr : SSQ_(l - 1, 1), BIAS_M(l), NQKVA}; pg8::gemm_phase<pg8::EpiQKVA, pg8::StaticOrder, true, true>(lds, g, S, E); } PHASE_END
            PHASE_BEGIN for (int rep_ = 0; rep_ < REP_M24; ++rep_) { { pg8::Gemm g = pg8::plain_gemm(CQ_, QLORA, (const bf16_t*)(WB_MLA + OFF_WQB), QLORA, QLORA); pg8::StaticOrder S; S.init(Mq, NH * QKD, G, bx);
                  pg8::EpiBf16<0> E{QRAW_, NH * QKD, SSQQ_, nullptr, 0, 1.f / QLORA, true}; pg8::gemm_phase<pg8::EpiBf16<0>, pg8::StaticOrder, true, true>(lds, g, S, E); }
                { pg8::Gemm g = pg8::plain_gemm(CKV_, KVLORA, (const bf16_t*)(WB_MLA + OFF_WKVB), KVLORA, KVLORA); pg8::StaticOrder S; S.init(Mrows, NH * 256, G, G - 1 - bx);
                  pg8::EpiKV E{KVRAW_, KPE_, QKVA_, SSQKV_, SSQKP_, ka.in(I_KN) + j * QKD, (const float*)(ws + WS_ROPE), (LAS float*)(lds + 131072)}; pg8::gemm_phase<pg8::EpiKV, pg8::StaticOrder, true, true>(lds, g, S, E); } } PHASE_END
            PHASE_BEGIN {
#ifndef NO_ATT
                for (int rep_ = 0; rep_ < REP_ATT; ++rep_)
                for (int u = vcu; u < NB * NH * (SEQ / 256); u += G) { const int bh = u >> 4, qb = u & 15, b = bh >> 3, h = bh & 7;
                    att::attn_unit(QRAW_, KVRAW_, KPE_, O_, h, b * SEQ + qb * 256, MLAT + b * CTX, b * SEQ, (CTX + SEQ) / 64, (char*)lds_raw, ka.in(I_QN) + j * QKD, (const float*)(ws + WS_ROPE), true); }
                if (l == 0) for (int u = vcu; u < NB * NH; u += G) { const int b = u >> 3, h = u & 7;
                    att::attn_unit(QRAW_, KVRAW_, KPE_, O_, h, MLAT + b * CTX, MLAT + b * CTX, 0, CTX / 64, (char*)lds_raw, ka.in(I_QN) + j * QKD, (const float*)(ws + WS_ROPE), false); }
#endif
            } PHASE_END
            PHASE_BEGIN { { pg8::Gemm g = pg8::plain_gemm(O_, DM, (const bf16_t*)(WB_MLA + OFF_WO), DM, DM); pg8::StaticOrder S; S.init(MLAT, DM, G, bx);
                pg8::EpiResidFuse E{XLAT, ka.out(), MODL + 2 * DM, HB_, ka.in(I_NFG) + l * DM, MODL + 4 * DM, SSQ_(l, 0), (LAS float*)(lds + 131072)}; pg8::gemm_phase<pg8::EpiResidFuse, pg8::StaticOrder, true, true>(lds, g, S, E); }
                if (Mres > MLAT) CTX_SPLIT_GEMM(O_, DM, (const bf16_t*)(WB_MLA + OFF_WO), 4, 2 * DM); } PHASE_END
        } else {
            if (l == 1) { PHASE_BEGIN modulate_ctx_phase(XCTX, ka.in(I_NMG) + l * DM, MODL, 0, DM, HB_, gw, NGW, lane, SLAB_, 8, XC_); PHASE_END }
            PHASE_BEGIN for (int rep_ = 0; rep_ < REP_G2; ++rep_) { { pg8::Gemm g = pg8::plain_gemm(HB_, DM, (const bf16_t*)(WB_GM + OFF_WIN), DM, DM); pg8::StaticOrder S; S.init(Mres, GMH, G, bx);
                  pg8::EpiBf16<1> E{GU_, GMH, SSQ_(l - 1, 1), BIAS_M(l), 2 * GMH, 1.f / DM, false}; pg8::gemm_phase<pg8::EpiBf16<1>, pg8::StaticOrder, true, true>(lds, g, S, E); }
                { pg8::Gemm g = pg8::plain_gemm((const bf16_t*)(WB_GM + OFF_WIN) + (size_t)GMH * DM, DM, HB_, DM, DM); pg8::StaticOrder S; S.init(GMH, Mres, G, G - 1 - bx);
                  pg8::EpiGeluT E{GVT_, MALL, S1_, S2_, SSQ_(l - 1, 1), BIAS_M(l) + GMH, 2 * GMH}; pg8::gemm_phase<pg8::EpiGeluT, pg8::StaticOrder, true, true>(lds, g, S, E); } } PHASE_END
            PHASE_BEGIN { pg8::Gemm g; g.A = (const char*)(WB_GM + OFF_WBLK); g.B = (const char*)GVT_; g.lda = 256; g.ldb = MALL; g.K = 256;
                g.sAm = 0; g.sAn = (size_t)256 * 256 * 2; g.sBm = (size_t)256 * 2; g.sBn = (size_t)256 * MALL * 2;
                pg8::StaticOrder S; S.init(Mres, GMH, G, bx);
                { pg8::Unit uu; for (int i = 0; S.next(i, uu); ++i) gm_ln_block(GVT_, S1_, S2_, ka.in(I_GLNG) + j * GMH, ka.in(I_GLNB) + j * GMH, uu.pn * 256, uu.pm * 256, tid);
                  asm volatile("s_waitcnt vmcnt(0)" ::: "memory"); __builtin_amdgcn_fence(__ATOMIC_ACQUIRE, "agent"); asm volatile("s_waitcnt vmcnt(0)" ::: "memory"); __syncthreads(); }
                pg8::EpiGate E{GU_, GMH, ka.in(I_GBS) + j * 8 * 128}; pg8::gemm_phase<pg8::EpiGate, pg8::StaticOrder, true, true>(lds, g, S, E); } PHASE_END
            PHASE_BEGIN { { pg8::Gemm g = pg8::plain_gemm(GU_, GMH, (const bf16_t*)(WB_GM + OFF_WOUT), GMH, GMH); pg8::StaticOrder S; S.init(MLAT, DM, G, bx);
                pg8::EpiResidFuse E{XLAT, ka.out(), MODL + 2 * DM, HB_, ka.in(I_NFG) + l * DM, MODL + 4 * DM, SSQ_(l, 0), (LAS float*)(lds + 131072)}; pg8::gemm_phase<pg8::EpiResidFuse, pg8::StaticOrder, true, true>(lds, g, S, E); }
                if (Mres > MLAT) CTX_SPLIT_GEMM(GU_, GMH, (const bf16_t*)(WB_GM + OFF_WOUT), 8, 2 * DM); } PHASE_END
        }
        if (l <= 1) { PHASE_BEGIN modulate_ctx_phase(XCTX, ka.in(I_NFG) + l * DM, MODL, 3 * DM, 4 * DM, HB_, gw, NGW, lane, SLAB_, l == 0 ? 4 : 8, XC_); PHASE_END }
        PHASE_BEGIN for (int rep_ = 0; rep_ < REP_F2; ++rep_) { pg8::Gemm g = pg8::plain_gemm(HB_, DM, (const bf16_t*)(ws + WS_W1 + l * W_FFN_STRIDE), DM, DM); pg8::StaticOrder S; S.init(Mres, FFH, G, bx);
            pg8::EpiBf16<2> E{FH_, FFH, SSQ_(l, 0), BIAS_F(l), FFH, 1.f / DM, false}; pg8::gemm_phase<pg8::EpiBf16<2>, pg8::StaticOrder, true, true>(lds, g, S, E); } PHASE_END
        PHASE_BEGIN { if (l >= 2) for (int rep_ = 0; rep_ < REP_F3X; ++rep_) { pg8::Gemm g = pg8::plain_gemm(FH_, FFH, (const bf16_t*)(ws + WS_W2 + l * W_FFN_STRIDE), FFH, FFH); pg8::StaticOrder S; S.init(MLAT, DM, G, bx);
            pg8::EpiBf16<0> E{(bf16_t*)(ws + WS_QKVA), DM, nullptr, nullptr, 0, 1.f, false}; pg8::gemm_phase<pg8::EpiBf16<0>, pg8::StaticOrder, true, true>(lds, g, S, E); }
 { pg8::Gemm g = pg8::plain_gemm(FH_, FFH, (const bf16_t*)(ws + WS_W2 + l * W_FFN_STRIDE), FFH, FFH); pg8::StaticOrder S; S.init(MLAT, DM, G, bx);
            if (l < DEPTH - 1) { pg8::EpiResidFuse E{ka.out(), ka.out(), MODL + 5 * DM, HB_, ka.in(I_NMG) + (l + 1) * DM, MODN + DM, SSQ_(l, 1), (LAS float*)(lds + 131072)}; pg8::gemm_phase<pg8::EpiResidFuse, pg8::StaticOrder, true, true>(lds, g, S, E); }
            else { pg8::EpiResid E{ka.out(), XC_, ka.out(), XC_, MODL + 5 * DM}; pg8::gemm_phase<pg8::EpiResid, pg8::StaticOrder, true, true>(lds, g, S, E); } }
            if (Mres > MLAT) CTX_SPLIT_GEMM(FH_, FFH, (const bf16_t*)(ws + WS_W2 + l * W_FFN_STRIDE), 8, 5 * DM); } PHASE_END
    }
#undef PHASE_BEGIN
#undef PHASE_END
}
constexpr int NPHASES = 1 + 8 + 7 + 7 + 5;

extern "C" void kernel_launch(void* const* d_in, const int* in_sizes, int n_in, void* d_out, int out_size, void* d_ws, size_t ws_size, hipStream_t stream) {
    static int grid = 0;
    if (grid == 0) {
        if (n_in != 25 || out_size != MLAT * DM || ws_size < WS_END) { fprintf(stderr, "kernel_launch: unexpected shapes: n_in %d out %d ws %zu (need %zu)\n", n_in, out_size, ws_size, (size_t)WS_END); grid = -1; return; }
        int dev = 0, cus = 0, per_cu = 0;
        hipGetDevice(&dev); hipDeviceGetAttribute(&cus, hipDeviceAttributeMultiprocessorCount, dev);
        if (hipFuncSetAttribute((const void*)fwd_mega, hipFuncAttributeMaxDynamicSharedMemorySize, LDS_BYTES) != hipSuccess) { fprintf(stderr, "kernel_launch: hipFuncSetAttribute failed\n"); grid = -1; return; }
        hipOccupancyMaxActiveBlocksPerMultiprocessor(&per_cu, (const void*)fwd_mega, 512, LDS_BYTES);
        (void)hipGetLastError();
        if (per_cu < 1) per_cu = 1;
        grid = cus * per_cu;
        fprintf(stderr, "kernel_launch: cus %d per_cu %d grid %d\n", cus, per_cu, grid);
    }
    if (grid < 0) return;
    (void)hipMemsetAsync((char*)d_ws + WS_CTL, 0, CTL_ZERO_BYTES, stream);
    Args a{};
    for (int i = 0; i < 25; ++i) a.in[i] = (const float*)d_in[i];
    a.out = (float*)d_out; a.ws = (unsigned char*)d_ws;
#if ONE_LAUNCH
    a.ph_lo = 0; a.ph_hi = NPHASES;
    void* args[] = {&a};
    hipError_t e = hipLaunchCooperativeKernel((const void*)fwd_mega, dim3(grid), dim3(512), args, LDS_BYTES, stream);
    if (e != hipSuccess) fprintf(stderr, "kernel_launch: cooperative launch failed: %s (grid %d)\n", hipGetErrorString(e), grid);
#else
    for (int p = 0; p < NPHASES; ++p) { a.ph_lo = p; a.ph_hi = p + 1; hipLaunchKernelGGL(fwd_mega, dim3(grid), dim3(512), LDS_BYTES, stream, a); }
    hipError_t e = hipPeekAtLastError();
    if (e != hipSuccess) fprintf(stderr, "kernel_launch: launch failed: %s\n", hipGetErrorString(e));
#endif
}
```
